# Optimizing an MI355X kernel written in HIP

```python
import jax, jax.numpy as jnp
from jax import lax
import numpy as np

D_MODEL = 1024
BATCH = 2
SEQ = 8192
DEPTH = 2

GRID_W = 64
CTX_LEN = 256
N_MIXERS = 2
BLK = 128
WINDOW = 128
ROPE_BASE = 10000.0
EPS = 1e-6
NEG_INF = -1e30

A_HEADS = 16
A_KV_HEADS = 4
A_GROUP = A_HEADS // A_KV_HEADS
A_HEAD_DIM = 64
A_WIDTH = A_HEADS * A_HEAD_DIM
A_KV_WIDTH = A_KV_HEADS * A_HEAD_DIM
A_IN = A_WIDTH + 2 * A_KV_WIDTH + A_WIDTH

B_HEADS = 16
B_NOPE = 64
B_ROPE = 32
B_V = 64
B_Q_RANK = 256
B_KV_RANK = 128
B_WIDTH = B_HEADS * B_V
B_IN = B_Q_RANK + B_KV_RANK + B_ROPE + B_WIDTH

kernel_name = "hybrid_swa_sink_mla_dit_prefix"


def rmsnorm(x, g):
    xf = x.astype(jnp.float32)
    y = xf * lax.rsqrt(jnp.mean(xf * xf, axis=-1, keepdims=True) + EPS)
    return (y * g.astype(jnp.float32)).astype(x.dtype)


def axial_rope_tables(n_tokens, rot_dim, dtype):
    n_rows = n_tokens // GRID_W
    row = jnp.broadcast_to(jnp.arange(n_rows)[:, None], (n_rows, GRID_W)).reshape(-1)
    col = jnp.broadcast_to(jnp.arange(GRID_W)[None, :], (n_rows, GRID_W)).reshape(-1)
    nf = rot_dim // 4
    inv = ROPE_BASE ** (-jnp.arange(nf, dtype=jnp.float32) / nf)
    ar = row.astype(jnp.float32)[:, None] * inv
    ac = col.astype(jnp.float32)[:, None] * inv
    ang = jnp.concatenate([ar, ar, ac, ac], axis=-1)
    return jnp.cos(ang).astype(dtype), jnp.sin(ang).astype(dtype)


def apply_rope(x, cos, sin):
    a1, a2, b1, b2 = jnp.split(x, 4, axis=-1)
    rot = jnp.concatenate([-a2, a1, -b2, b1], axis=-1)
    shp = (x.shape[1],) + (1,) * (x.ndim - 3) + (x.shape[-1],)
    return x * cos.reshape(shp) + rot * sin.reshape(shp)


def modulate(x, g, shift, scale):
    return rmsnorm(x, g) * (1 + scale) + shift


def mixer_a(h, hc, w_in, sinks, w_o, cos, sin, ctx_out):
    bsz, S, _ = h.shape
    dt = h.dtype
    q, k, v, g = jnp.split(h @ w_in, [A_WIDTH, A_WIDTH + A_KV_WIDTH, A_WIDTH + 2 * A_KV_WIDTH], axis=-1)
    q = apply_rope(q.reshape(bsz, S, A_KV_HEADS, A_GROUP, A_HEAD_DIM), cos, sin)
    k = apply_rope(k.reshape(bsz, S, A_KV_HEADS, A_HEAD_DIM), cos, sin)
    v = v.reshape(bsz, S, A_KV_HEADS, A_HEAD_DIM)
    kvc = hc @ w_in[:, A_WIDTH:A_WIDTH + 2 * A_KV_WIDTH]
    kc, vc = jnp.split(kvc.reshape(bsz, -1, 2 * A_KV_HEADS, A_HEAD_DIM), 2, axis=2)
    sink_logit = sinks.astype(jnp.float32).reshape(A_KV_HEADS, A_GROUP)
    scale = A_HEAD_DIM ** -0.5
    kp = jnp.pad(k, ((0, 0), (BLK, BLK), (0, 0), (0, 0)))
    vp = jnp.pad(v, ((0, 0), (BLK, BLK), (0, 0), (0, 0)))

    def block(i):
        qs = lax.dynamic_slice_in_dim(q, i * BLK, BLK, axis=1)
        ks = lax.dynamic_slice_in_dim(kp, i * BLK, 3 * BLK, axis=1)
        vs = lax.dynamic_slice_in_dim(vp, i * BLK, 3 * BLK, axis=1)
        q_pos = i * BLK + jnp.arange(BLK)
        k_pos = (i - 1) * BLK + jnp.arange(3 * BLK)
        valid = (jnp.abs(q_pos[:, None] - k_pos[None, :]) <= WINDOW) & (k_pos >= 0)[None, :] & (k_pos < S)[None, :]
        s_loc = jnp.einsum('bqhgd,bkhd->bhgqk', qs, ks).astype(jnp.float32) * scale
        s_loc = jnp.where(valid, s_loc, NEG_INF)
        s_ctx = jnp.einsum('bqhgd,bkhd->bhgqk', qs, kc).astype(jnp.float32) * scale
        sink = jnp.broadcast_to(sink_logit[None, :, :, None, None], s_loc.shape[:-1] + (1,))
        p = jax.nn.softmax(jnp.concatenate([s_loc, s_ctx, sink], axis=-1), axis=-1).astype(dt)
        n_loc = 3 * BLK
        return (jnp.einsum('bhgqk,bkhd->bqhgd', p[..., :n_loc], vs)
                + jnp.einsum('bhgqk,bkhd->bqhgd', p[..., n_loc:-1], vc))

    o = lax.map(block, jnp.arange(S // BLK))
    o = jnp.moveaxis(o, 0, 1).reshape(bsz, S, A_WIDTH)
    y = (o * jax.nn.silu(g)) @ w_o
    if not ctx_out:
        return y, None
    C = hc.shape[1]
    qc = (hc @ w_in[:, :A_WIDTH]).reshape(bsz, C, A_KV_HEADS, A_GROUP, A_HEAD_DIM)
    gc = hc @ w_in[:, A_WIDTH + 2 * A_KV_WIDTH:]
    s = jnp.einsum('bqhgd,bkhd->bhgqk', qc, kc).astype(jnp.float32) * scale
    sink = jnp.broadcast_to(sink_logit[None, :, :, None, None], s.shape[:-1] + (1,))
    p = jax.nn.softmax(jnp.concatenate([s, sink], axis=-1), axis=-1)[..., :-1].astype(dt)
    oc = jnp.einsum('bhgqk,bkhd->bqhgd', p, vc).reshape(bsz, C, A_WIDTH)
    yc = (oc * jax.nn.silu(gc)) @ w_o
    return y, yc


def mixer_b(h, hc, w_in, q_norm_g, w_uq, kv_norm_g, w_ukv, w_o, cos, sin, ctx_out):
    bsz, S, _ = h.shape
    C = hc.shape[1]
    dt = h.dtype
    splits = [B_Q_RANK, B_Q_RANK + B_KV_RANK, B_Q_RANK + B_KV_RANK + B_ROPE]
    cq, ckv, kr, g = jnp.split(h @ w_in, splits, axis=-1)
    q = (rmsnorm(cq, q_norm_g) @ w_uq).reshape(bsz, S, B_HEADS, B_NOPE + B_ROPE)
    qn, qr = q[..., :B_NOPE], apply_rope(q[..., B_NOPE:], cos, sin)
    kv = (rmsnorm(ckv, kv_norm_g) @ w_ukv).reshape(bsz, S, B_HEADS, B_NOPE + B_V)
    kn, v = kv[..., :B_NOPE], kv[..., B_NOPE:]
    kr = apply_rope(kr, cos, sin)
    ckv_c, kr_c = jnp.split(hc @ w_in[:, B_Q_RANK:splits[2]], [B_KV_RANK], axis=-1)
    kv_c = (rmsnorm(ckv_c, kv_norm_g) @ w_ukv).reshape(bsz, C, B_HEADS, B_NOPE + B_V)
    kn_c, v_c = kv_c[..., :B_NOPE], kv_c[..., B_NOPE:]
    kn_all = jnp.concatenate([kn_c, kn], axis=1)
    kr_all = jnp.concatenate([kr_c, kr], axis=1)
    v_all = jnp.concatenate([v_c, v], axis=1)
    scale = (B_NOPE + B_ROPE) ** -0.5

    def block(i):
        qn_b = lax.dynamic_slice_in_dim(qn, i * BLK, BLK, axis=1)
        qr_b = lax.dynamic_slice_in_dim(qr, i * BLK, BLK, axis=1)
        s = (jnp.einsum('bqhd,bkhd->bhqk', qn_b, kn_all)
             + jnp.einsum('bqhr,bkr->bhqk', qr_b, kr_all)).astype(jnp.float32) * scale
        p = jax.nn.softmax(s, axis=-1).astype(dt)
        return jnp.einsum('bhqk,bkhd->bqhd', p, v_all)

    o = lax.map(block, jnp.arange(S // BLK))
    o = jnp.moveaxis(o, 0, 1).reshape(bsz, S, B_WIDTH)
    y = (o * jax.nn.silu(g)) @ w_o
    if not ctx_out:
        return y, None
    qc = (rmsnorm(hc @ w_in[:, :B_Q_RANK], q_norm_g) @ w_uq).reshape(bsz, C, B_HEADS, B_NOPE + B_ROPE)
    gc = hc @ w_in[:, splits[2]:]
    s = (jnp.einsum('bqhd,bkhd->bhqk', qc[..., :B_NOPE], kn_c)
         + jnp.einsum('bqhr,bkr->bhqk', qc[..., B_NOPE:], kr_c)).astype(jnp.float32) * scale
    p = jax.nn.softmax(s, axis=-1).astype(dt)
    oc = jnp.einsum('bhqk,bkhd->bqhd', p, v_c).reshape(bsz, C, B_WIDTH)
    yc = (oc * jax.nn.silu(gc)) @ w_o
    return y, yc


def setup_inputs(seed: int = 0) -> dict:
    key = jax.random.key(seed)
    ks = jax.random.split(key, 24)
    f = jnp.float32
    D = D_MODEL

    def w(k, shape, fan_in):
        return jax.random.normal(k, shape, f) * fan_in ** -0.5

    def gain(k, n):
        return 1.0 + 0.02 * jax.random.normal(k, (n,), f)

    return {
        "x": jax.random.normal(ks[0], (BATCH, SEQ, D), f),
        "c": jax.random.normal(ks[1], (BATCH, D), f),
        "ctx": jax.random.normal(ks[2], (BATCH, CTX_LEN, D), f),
        "c_ctx": jax.random.normal(ks[3], (D,), f),
        "norm_g_0": gain(ks[4], D),
        "ada_w_0": w(ks[5], (D, 3 * D), D),
        "ada_b_0": 0.02 * jax.random.normal(ks[6], (3 * D,), f),
        "a_w_in_0": w(ks[7], (D, A_IN), D),
        "a_sinks_0": 0.5 * jax.random.normal(ks[8], (A_HEADS,), f),
        "a_w_o_0": w(ks[9], (A_WIDTH, D), A_WIDTH),
        "norm_g_1": gain(ks[10], D),
        "ada_w_1": w(ks[11], (D, 3 * D), D),
        "ada_b_1": 0.02 * jax.random.normal(ks[12], (3 * D,), f),
        "b_w_in_1": w(ks[13], (D, B_IN), D),
        "b_q_norm_1": gain(ks[14], B_Q_RANK),
        "b_w_uq_1": w(ks[15], (B_Q_RANK, B_HEADS * (B_NOPE + B_ROPE)), B_Q_RANK),
        "b_kv_norm_1": gain(ks[16], B_KV_RANK),
        "b_w_ukv_1": w(ks[17], (B_KV_RANK, B_HEADS * (B_NOPE + B_V)), B_KV_RANK),
        "b_w_o_1": w(ks[18], (B_WIDTH, D), B_WIDTH),
        "final_g": gain(ks[19], D),
    }


def reference(x, c, ctx, c_ctx, norm_g_0, ada_w_0, ada_b_0, a_w_in_0, a_sinks_0, a_w_o_0,
              norm_g_1, ada_w_1, ada_b_1, b_w_in_1, b_q_norm_1, b_w_uq_1, b_kv_norm_1,
              b_w_ukv_1, b_w_o_1, final_g):
    S = x.shape[1]
    cos_a, sin_a = axial_rope_tables(S, A_HEAD_DIM, x.dtype)
    cos_b, sin_b = axial_rope_tables(S, B_ROPE, x.dtype)
    layers = [
        (norm_g_0, ada_w_0, ada_b_0, (a_w_in_0, a_sinks_0, a_w_o_0)),
        (norm_g_1, ada_w_1, ada_b_1, (b_w_in_1, b_q_norm_1, b_w_uq_1, b_kv_norm_1, b_w_ukv_1, b_w_o_1)),
    ]
    for i in range(DEPTH):
        g_norm, ada_w, ada_b, mp = layers[i]
        last = i == DEPTH - 1
        shift, scale, gate = jnp.split(jax.nn.silu(c) @ ada_w + ada_b, 3, axis=-1)
        shift_c, scale_c, gate_c = jnp.split(jax.nn.silu(c_ctx) @ ada_w + ada_b, 3, axis=-1)
        h = modulate(x, g_norm, shift[:, None], scale[:, None])
        hc = modulate(ctx, g_norm, shift_c, scale_c)
        if i % N_MIXERS == 0:
            y, yc = mixer_a(h, hc, *mp, cos_a, sin_a, not last)
        else:
            y, yc = mixer_b(h, hc, *mp, cos_b, sin_b, not last)
        x = x + gate[:, None] * y
        if not last:
            ctx = ctx + gate_c * yc
    return rmsnorm(x, final_g)
```

```cpp
#include <hip/hip_runtime.h>
#include <hip/hip_cooperative_groups.h>
#include <cstdio>
#include <cstdint>
namespace cg = cooperative_groups;

#ifndef N_LAUNCH_MODE
#define N_LAUNCH_MODE 1
#endif

typedef unsigned short bf16_t;
typedef short bf16x8 __attribute__((ext_vector_type(8)));
typedef float f32x16 __attribute__((ext_vector_type(16)));
typedef float f32x4 __attribute__((ext_vector_type(4)));
typedef float f32x2 __attribute__((ext_vector_type(2)));
typedef unsigned u32x4 __attribute__((ext_vector_type(4)));
typedef unsigned u32x2 __attribute__((ext_vector_type(2)));
typedef __bf16 bf16x2_t __attribute__((ext_vector_type(2)));

#define DI __device__ __forceinline__
#define GAS __attribute__((address_space(1)))
#define LAS __attribute__((address_space(3)))
#define MFMA(a, b, c) __builtin_amdgcn_mfma_f32_32x32x16_bf16((a), (b), (c), 0, 0, 0)

constexpr int D = 1024, SEQ = 8192, CTX = 256;
constexpr int MLAT = 2 * SEQ;
constexpr int MCTX = 2 * CTX;
constexpr int MTOT = MLAT + MCTX;
constexpr int KVKEYS = SEQ + CTX;
constexpr float EPS = 1e-6f;
constexpr float LOG2E = 1.4426950408889634f;
constexpr float QSCALE_A = 0.125f * 1.4426950408889634f;
constexpr float QSCALE_B = (float)(0.10206207261596575 * 1.4426950408889634);

constexpr size_t WS_MODS = 0;
constexpr size_t WS_ROPEA = WS_MODS + 2 * 3 * 3072 * 4;
constexpr size_t WS_ROPEB = WS_ROPEA + 128 * 16 * 8;
constexpr size_t WS_WT_IN0 = WS_ROPEB + 128 * 8 * 8;
constexpr size_t WS_WT_O0 = WS_WT_IN0 + (size_t)2560 * 1024 * 2;
constexpr size_t WS_WT_IN1 = WS_WT_O0 + (size_t)1024 * 1024 * 2;
constexpr size_t WS_WT_UQ = WS_WT_IN1 + (size_t)1536 * 1024 * 2;
constexpr size_t WS_WT_UKV = WS_WT_UQ + (size_t)1536 * 256 * 2;
constexpr size_t WS_WT_O1 = WS_WT_UKV + (size_t)2048 * 128 * 2;
constexpr size_t WS_CTX1 = WS_WT_O1 + (size_t)1024 * 1024 * 2;
constexpr size_t WS_H = WS_CTX1 + (size_t)MCTX * D * 4;
constexpr size_t WS_SG = WS_H + (size_t)MTOT * D * 2;
constexpr size_t WS_CQN = WS_SG + (size_t)MTOT * D * 2;
constexpr size_t WS_CKVN = WS_CQN + (size_t)MTOT * 256 * 2;
constexpr size_t WS_BIG = WS_CKVN + (size_t)MTOT * 128 * 2;
constexpr size_t WS_Q0 = WS_BIG;
constexpr size_t WS_K0 = WS_Q0 + (size_t)MTOT * D * 2;
constexpr size_t WS_VT0 = WS_K0 + (size_t)MTOT * 256 * 2;
constexpr size_t WS_OG0 = WS_VT0 + (size_t)2 * 256 * KVKEYS * 2;
constexpr size_t WS_Q1 = WS_BIG;
constexpr size_t WS_C416 = WS_BIG;
constexpr int KROW = 240;
constexpr int KV_VOFF = 64 * KROW;
constexpr int KV_TILE_BYTES = KV_VOFF + 64 * 144;
constexpr int KV_NT = KVKEYS / 64;
constexpr size_t WS_KV = WS_Q1 + (size_t)MLAT * 1536 * 2;
constexpr size_t WS_BAR = WS_KV + (size_t)32 * KV_NT * KV_TILE_BYTES;
constexpr size_t WS_SSQ = WS_BAR + 16384;
constexpr size_t WS_END = WS_SSQ + (size_t)2 * MTOT * 4;
static_assert(WS_END <= (size_t)256 * 1024 * 1024, "workspace map exceeds 256 MiB");

constexpr int LDS_BYTES = 2 * 512 * 144;
constexpr int NPHASE = 12;

struct Params {
    const float* in[20];
    float* out;
    unsigned char* ws;
    int ph_lo, ph_hi;
};

DI unsigned pk2(float a, float b) { f32x2 v = {a, b}; bf16x2_t r = __builtin_convertvector(v, bf16x2_t); return __builtin_bit_cast(unsigned, r); }
DI float bflo(unsigned u) { return __uint_as_float(u << 16); }
DI float bfhi(unsigned u) { return __uint_as_float(u & 0xffff0000u); }
DI float wave_sum(float v) {
#pragma unroll
    for (int o = 1; o < 64; o <<= 1) v += __shfl_xor(v, o);
    return v;
}
DI float silu_f(float v) { return v * __builtin_amdgcn_rcpf(1.f + __builtin_amdgcn_exp2f(-1.4426950408889634f * v)); }
DI float ex2(float v) { return __builtin_amdgcn_exp2f(v); }

DI void p0_transpose_unit(const float* W, int K, int N, int Npad, bf16_t* Wt, int r, float* tile, int tid, const float* kscale = nullptr) {
    const int ntn = Npad / 64, nt = r % ntn, kt = r / ntn, n0 = nt * 64, k0 = kt * 64;
#pragma unroll
    for (int j = 0; j < 8; ++j) {
        const int kk = (tid >> 6) + 8 * j, nn = tid & 63, n = n0 + nn;
        tile[kk * 65 + nn] = (n < N) ? W[(size_t)(k0 + kk) * N + n] * (kscale ? kscale[k0 + kk] : 1.f) : 0.f;
    }
    __syncthreads();
    {
        const int nn = tid >> 3, kk8 = (tid & 7) * 8;
        u32x4 o;
        o.x = pk2(tile[(kk8 + 0) * 65 + nn], tile[(kk8 + 1) * 65 + nn]);
        o.y = pk2(tile[(kk8 + 2) * 65 + nn], tile[(kk8 + 3) * 65 + nn]);
        o.z = pk2(tile[(kk8 + 4) * 65 + nn], tile[(kk8 + 5) * 65 + nn]);
        o.w = pk2(tile[(kk8 + 6) * 65 + nn], tile[(kk8 + 7) * 65 + nn]);
        *(u32x4*)(Wt + (size_t)(n0 + nn) * K + k0 + kk8) = o;
    }
    __syncthreads();
}

DI void p0_ada_unit(const Params& p, unsigned char* ws, int u, float* lds, int tid) {
    const int l = u / 96, n0 = (u % 96) * 32;
    const float* W = p.in[l ? 11 : 5];
    const float* bias = p.in[l ? 12 : 6];
    float* sv = lds;
    float* red = lds + 3 * 1024;
    for (int e = tid; e < 3 * 1024; e += 512) {
        const int v = e >> 10, k = e & 1023;
        const float cv = (v < 2) ? p.in[1][v * 1024 + k] : p.in[3][k];
        sv[e] = silu_f(cv);
    }
    __syncthreads();
    const int col = tid & 31, kg = tid >> 5;
    float a0 = 0.f, a1 = 0.f, a2 = 0.f;
#pragma unroll 8
    for (int kk = 0; kk < 64; ++kk) {
        const int k = kg * 64 + kk;
        const float wv = W[(size_t)k * 3072 + n0 + col];
        a0 += sv[k] * wv; a1 += sv[1024 + k] * wv; a2 += sv[2048 + k] * wv;
    }
    red[(kg * 3 + 0) * 32 + col] = a0; red[(kg * 3 + 1) * 32 + col] = a1; red[(kg * 3 + 2) * 32 + col] = a2;
    __syncthreads();
    if (tid < 96) {
        const int v = tid >> 5, c2 = tid & 31;
        float s = bias[n0 + c2];
#pragma unroll
        for (int g = 0; g < 16; ++g) s += red[(g * 3 + v) * 32 + c2];
        ((float*)(ws + WS_MODS))[(l * 3 + v) * 3072 + n0 + c2] = s;
    }
    __syncthreads();
}

DI void phase0(const Params& p, unsigned char* ws, unsigned char* ldsb, int tid) {
    float* lds = (float*)ldsb;
    constexpr int U_ADA = 192, U_ROPE = 6;
    constexpr int U_IN0 = (2560 / 64) * (1024 / 64), U_O = (1024 / 64) * (1024 / 64), U_IN1 = (1536 / 64) * (1024 / 64),
                  U_UQ = (1536 / 64) * (256 / 64), U_UKV = (2048 / 64) * (128 / 64);
    constexpr int NU = U_ADA + U_ROPE + U_IN0 + U_O + U_IN1 + U_UQ + U_UKV + U_O;
    { float* ssq = (float*)(ws + WS_SSQ); for (int e = blockIdx.x * 512 + tid; e < 2 * MTOT; e += gridDim.x * 512) ssq[e] = 0.f; }
    for (int u = blockIdx.x; u < NU; u += gridDim.x) {
        int r = u;
        if (r < U_ADA) { p0_ada_unit(p, ws, r, lds, tid); continue; } r -= U_ADA;
        if (r < U_ROPE) {
            const int e = r * 512 + tid;
            if (e < 2048) { const int pos = e >> 4, j = e & 15; const float inv = powf(10000.f, -(float)j / 16.f); const float a = (float)pos * inv;
                ((f32x2*)(ws + WS_ROPEA))[e] = (f32x2){cosf(a), sinf(a)}; }
            else { const int e2 = e - 2048; const int pos = e2 >> 3, j = e2 & 7; const float inv = powf(10000.f, -(float)j / 8.f); const float a = (float)pos * inv;
                ((f32x2*)(ws + WS_ROPEB))[e2] = (f32x2){cosf(a), sinf(a)}; }
            continue;
        } r -= U_ROPE;
        if (r < U_IN0) { p0_transpose_unit(p.in[7], 1024, 2560, 2560, (bf16_t*)(ws + WS_WT_IN0), r, lds, tid); continue; } r -= U_IN0;
        if (r < U_O) { p0_transpose_unit(p.in[9], 1024, 1024, 1024, (bf16_t*)(ws + WS_WT_O0), r, lds, tid); continue; } r -= U_O;
        if (r < U_IN1) { p0_transpose_unit(p.in[13], 1024, 1440, 1536, (bf16_t*)(ws + WS_WT_IN1), r, lds, tid); continue; } r -= U_IN1;
        if (r < U_UQ) { p0_transpose_unit(p.in[15], 256, 1536, 1536, (bf16_t*)(ws + WS_WT_UQ), r, lds, tid, p.in[14]); continue; } r -= U_UQ;
        if (r < U_UKV) { p0_transpose_unit(p.in[17], 128, 2048, 2048, (bf16_t*)(ws + WS_WT_UKV), r, lds, tid, p.in[16]); continue; } r -= U_UKV;
        p0_transpose_unit(p.in[18], 1024, 1024, 1024, (bf16_t*)(ws + WS_WT_O1), r, lds, tid);
    }
}

template <bool LAT_BF16>
DI void modulate_phase(const float* xlat, const float* xctx, const float* g, const float* mods_l, bf16_t* h, int tid) {
    const int lane = tid & 63, gw = blockIdx.x * 8 + (tid >> 6), ngw = gridDim.x * 8;
    for (int row0 = gw; row0 < MTOT; row0 += 2 * ngw) {
        const float* src[2]; const float* md[2]; int row[2]; bool ok[2];
        f32x4 v[2][4];
#pragma unroll
        for (int q = 0; q < 2; ++q) {
            row[q] = row0 + q * ngw; ok[q] = row[q] < MTOT;
            const int rr = ok[q] ? row[q] : row0;
            if (rr < MLAT) { src[q] = xlat + (size_t)rr * D; md[q] = mods_l + (rr >> 13) * 3072; }
            else { src[q] = xctx + (size_t)(rr - MLAT) * D; md[q] = mods_l + 2 * 3072; }
#pragma unroll
            for (int j = 0; j < 4; ++j) {
                if (LAT_BF16 && rr < MLAT) {
                    const u32x2 b2 = *(const GAS u32x2*)((const bf16_t*)xlat + (size_t)rr * D + lane * 4 + 256 * j);
                    v[q][j] = (f32x4){bflo(b2.x), bfhi(b2.x), bflo(b2.y), bfhi(b2.y)};
                } else v[q][j] = *(const GAS f32x4*)(src[q] + lane * 4 + 256 * j);
            }
        }
#pragma unroll
        for (int q = 0; q < 2; ++q) {
            float ss = 0.f;
#pragma unroll
            for (int j = 0; j < 4; ++j) ss += (v[q][j].x * v[q][j].x + v[q][j].y * v[q][j].y) + (v[q][j].z * v[q][j].z + v[q][j].w * v[q][j].w);
            const float rstd = 1.f / sqrtf(wave_sum(ss) * (1.f / D) + EPS);
            if (ok[q]) {
#pragma unroll
                for (int j = 0; j < 4; ++j) {
                    const int k = lane * 4 + 256 * j;
                    const f32x4 gg = *(const GAS f32x4*)(g + k), sh = *(const GAS f32x4*)(md[q] + k), sc = *(const GAS f32x4*)(md[q] + 1024 + k);
                    const f32x4 o = (v[q][j] * rstd * gg) * (sc + 1.f) + sh;
                    u32x2 w; w.x = pk2(o.x, o.y); w.y = pk2(o.z, o.w);
                    *(GAS u32x2*)(h + (size_t)row[q] * D + k) = w;
                }
            }
        }
    }
}

template <class Epi>
DI void gemm_phase(const bf16_t* A, const bf16_t* Wt, int Mtiles, int Ntiles, int K, const Epi& epi, unsigned char* lds, int tid) {
    const int lane = tid & 63, w = tid >> 6, wt = w >> 2, wf = w & 3, r = lane & 31, hh = lane >> 5;
    const int wu = __builtin_amdgcn_readfirstlane(w);
    const int nk = K >> 6;
    const unsigned swz = (r >> 1) & 7;
    unsigned koff[4];
#pragma unroll
    for (int ks = 0; ks < 4; ++ks) koff[ks] = ((unsigned)(ks * 2 + hh) ^ swz) << 4;
    const int drow = 8 * w + (lane >> 3);
    const int dch = (lane & 7) ^ ((drow >> 1) & 7);
    const size_t dsrc = (size_t)drow * K + dch * 8;
#define G_DMA(kt_, st_)                                                                               \
    _Pragma("unroll") for (int j = 0; j < 4; ++j) {                                                    \
        __builtin_amdgcn_global_load_lds((const GAS unsigned*)(Ag + (size_t)(j * 64) * K + (kt_) * 64), (LAS unsigned*)(lds + (st_) * 65536 + (j * 8 + wu) * 1024), 16, 0, 0); \
        __builtin_amdgcn_global_load_lds((const GAS unsigned*)(Wg + (size_t)(j * 64) * K + (kt_) * 64), (LAS unsigned*)(lds + (st_) * 65536 + 32768 + (j * 8 + wu) * 1024), 16, 0, 0); \
    }
#define G_BARRIER() { asm volatile("s_waitcnt vmcnt(0) lgkmcnt(0)" ::: "memory"); __builtin_amdgcn_s_barrier(); asm volatile("" ::: "memory"); }
    const int nx = (gridDim.x == 256) ? 8 : 1, xcd = blockIdx.x % nx, nslots = gridDim.x / nx;
    const int nloc = ((Mtiles - xcd + nx - 1) / nx) * Ntiles;
    int u = blockIdx.x / nx;
    const GAS bf16_t* Ag = (const GAS bf16_t*)A + dsrc;
    const GAS bf16_t* Wg = (const GAS bf16_t*)Wt + dsrc;
    if (u < nloc) {
        Ag = (const GAS bf16_t*)(A + (size_t)(xcd + nx * (u / Ntiles)) * 256 * K) + dsrc; Wg = (const GAS bf16_t*)(Wt + (size_t)(u % Ntiles) * 256 * K) + dsrc;
        G_DMA(0, 0);
    }
    while (u < nloc) {
        const int nt = u % Ntiles, mt = xcd + nx * (u / Ntiles);
        f32x16 acc[2][4];
#pragma unroll
        for (int a = 0; a < 2; ++a)
#pragma unroll
            for (int b = 0; b < 4; ++b)
#pragma unroll
                for (int i = 0; i < 16; ++i) acc[a][b][i] = 0.f;
        G_BARRIER();
        for (int kt = 0; kt < nk; ++kt) {
            if (kt + 1 < nk) { G_DMA(kt + 1, (kt + 1) & 1); }
            const unsigned char* sa = lds + (kt & 1) * 65536 + (wt * 128 + r) * 128;
            const unsigned char* sw = lds + (kt & 1) * 65536 + 32768 + (wf * 64 + r) * 128;
#pragma unroll
            for (int ks = 0; ks < 4; ++ks) {
                bf16x8 wfr[2], afr[4];
#pragma unroll
                for (int fb = 0; fb < 2; ++fb) wfr[fb] = *(const bf16x8*)(sw + fb * 4096 + koff[ks]);
#pragma unroll
                for (int tb = 0; tb < 4; ++tb) afr[tb] = *(const bf16x8*)(sa + tb * 4096 + koff[ks]);
#pragma unroll
                for (int fb = 0; fb < 2; ++fb)
#pragma unroll
                    for (int tb = 0; tb < 4; ++tb) acc[fb][tb] = MFMA(wfr[fb], afr[tb], acc[fb][tb]);
            }
            G_BARRIER();
        }
        const int un = u + nslots;
        if (un < nloc) {
            Ag = (const GAS bf16_t*)(A + (size_t)(xcd + nx * (un / Ntiles)) * 256 * K) + dsrc; Wg = (const GAS bf16_t*)(Wt + (size_t)(un % Ntiles) * 256 * K) + dsrc;
            G_DMA(0, 0);
        }
#pragma unroll
        for (int fb = 0; fb < 2; ++fb)
#pragma unroll
            for (int tb = 0; tb < 4; ++tb) epi(nt * 256 + wf * 64 + fb * 32, mt * 256 + wt * 128 + tb * 32, acc[fb][tb], r, hh);
        u = un;
    }
    asm volatile("s_waitcnt vmcnt(0)" ::: "memory");
#undef G_DMA
#undef G_BARRIER
}

DI void store_bf16x4(bf16_t* dst, float a, float b, float c, float d) { u32x2 w; w.x = pk2(a, b); w.y = pk2(c, d); *(GAS u32x2*)dst = w; }
DI void store_bf16_row32(bf16_t* rowp, const float (&v)[16], int hh) {
#pragma unroll
    for (int p = 0; p < 2; ++p) {
        unsigned ax = pk2(v[8 * p + 0], v[8 * p + 1]), ay = pk2(v[8 * p + 2], v[8 * p + 3]);
        unsigned bx = pk2(v[8 * p + 4], v[8 * p + 5]), by = pk2(v[8 * p + 6], v[8 * p + 7]);
        const auto rx = __builtin_amdgcn_permlane32_swap(ax, bx, false, false);
        const auto ry = __builtin_amdgcn_permlane32_swap(ay, by, false, false);
        u32x4 w; w.x = rx[0]; w.y = ry[0]; w.z = rx[1]; w.w = ry[1];
        *(GAS u32x4*)(rowp + 16 * p + 8 * hh) = w;
    }
}
DI void store_bf16_tr32(bf16_t* out, size_t ld, const f32x16& acc, unsigned char* patch, int r, int hh) {
#pragma unroll
    for (int i = 0; i < 16; ++i) { const int f = (i & 3) + 8 * (i >> 2) + 4 * hh; *(bf16_t*)(patch + f * 80 + r * 2) = (bf16_t)(pk2(acc[i], 0.f) & 0xffffu); }
    const int lane = r + 32 * hh;
#pragma unroll
    for (int q = 0; q < 2; ++q) {
        const int ch = lane + 64 * q, f = ch >> 2, tc = ch & 3;
        const u32x4 wv = *(const u32x4*)(patch + f * 80 + tc * 16);
        *(GAS u32x4*)(out + (size_t)f * ld + tc * 8) = wv;
    }
}
DI void store_bf16(bf16_t* dst, float a) { *(GAS bf16_t*)dst = (bf16_t)(pk2(a, 0.f) & 0xffffu); }

struct EpiNull {
    float* sink;
    DI void operator()(int fbase, int tbase, const f32x16& acc, int r, int hh) const {
        float s = 0.f;
#pragma unroll
        for (int i = 0; i < 16; ++i) s += acc[i];
        if (s == 123.456f) sink[0] = s;
    }
};
struct EpiAin {
    bf16_t* q0; bf16_t* k0; bf16_t* vt0; bf16_t* sg; const f32x2* ropeA; unsigned char* patch;
    DI void operator()(int fbase, int tbase, const f32x16& acc, int r, int hh) const {
        const int t = tbase + r;
        const bool latent = t < MLAT;
        if (fbase < 1280) {
            f32x16 v = acc;
            if (latent) {
                const int pos = t & (SEQ - 1);
                const int pp = (fbase & 32) ? (pos & 63) : (pos >> 6);
                const f32x2* tab = ropeA + pp * 16;
#pragma unroll
                for (int i = 0; i < 8; ++i) {
                    const int j = (i & 3) + 8 * (i >> 2) + 4 * hh;
                    const f32x2 cs = tab[j];
                    const float a = acc[i], b = acc[i + 8];
                    v[i] = a * cs.x - b * cs.y; v[i + 8] = b * cs.x + a * cs.y;
                }
            }
            float o[16];
            if (fbase < 1024) {
#pragma unroll
                for (int i = 0; i < 16; ++i) o[i] = v[i] * QSCALE_A;
                store_bf16_row32(q0 + (size_t)t * 1024 + fbase, o, hh);
            } else {
#pragma unroll
                for (int i = 0; i < 16; ++i) o[i] = v[i];
                store_bf16_row32(k0 + (size_t)t * 256 + (fbase - 1024), o, hh);
            }
        } else if (fbase < 1536) {
            const int f0 = fbase - 1280;
            int b, key;
            if (latent) { b = t >> 13; key = t & (SEQ - 1); } else { const int tc = t - MLAT; b = tc >> 8; key = SEQ + (tc & 255); }
            store_bf16_tr32(vt0 + (size_t)(b * 256 + f0) * KVKEYS + (key - r), KVKEYS, acc, patch, r, hh);
        } else {
            float o[16];
#pragma unroll
            for (int i = 0; i < 16; ++i) o[i] = silu_f(acc[i]);
            store_bf16_row32(sg + (size_t)t * 1024 + (fbase - 1536), o, hh);
        }
    }
};

struct EpiWo0 {
    const float* xres; bf16_t* xb; const float* cres; float* cdst; const float* mods_l;
    DI void operator()(int fbase, int tbase, const f32x16& acc, int r, int hh) const {
        const int t = tbase + r;
        if (t < MLAT) {
            const float* res = xres + (size_t)t * D; const float* gate = mods_l + (t >> 13) * 3072 + 2048;
            float o[16];
#pragma unroll
            for (int g = 0; g < 4; ++g) {
                const int f = fbase + 8 * g + 4 * hh;
                const f32x4 rr = *(const GAS f32x4*)(res + f), gg = *(const GAS f32x4*)(gate + f);
                o[4 * g] = rr.x + gg.x * acc[4 * g]; o[4 * g + 1] = rr.y + gg.y * acc[4 * g + 1]; o[4 * g + 2] = rr.z + gg.z * acc[4 * g + 2]; o[4 * g + 3] = rr.w + gg.w * acc[4 * g + 3];
            }
            store_bf16_row32(xb + (size_t)t * D + fbase, o, hh);
        } else {
            const float* res = cres + (size_t)(t - MLAT) * D; float* dst = cdst + (size_t)(t - MLAT) * D; const float* gate = mods_l + 2 * 3072 + 2048;
#pragma unroll
            for (int g = 0; g < 4; ++g) {
                const int f = fbase + 8 * g + 4 * hh;
                const f32x4 rr = *(const GAS f32x4*)(res + f), gg = *(const GAS f32x4*)(gate + f);
                f32x4 o; o.x = rr.x + gg.x * acc[4 * g]; o.y = rr.y + gg.y * acc[4 * g + 1]; o.z = rr.z + gg.z * acc[4 * g + 2]; o.w = rr.w + gg.w * acc[4 * g + 3];
                *(GAS f32x4*)(dst + f) = o;
            }
        }
    }
};
struct EpiWo1 {
    const bf16_t* xb; bf16_t* x2b; const float* mods_l;
    DI void operator()(int fbase, int tbase, const f32x16& acc, int r, int hh) const {
        const int t = tbase + r;
        const bf16_t* res = xb + (size_t)t * D; const float* gate = mods_l + (t >> 13) * 3072 + 2048;
        float o[16];
#pragma unroll
        for (int g = 0; g < 4; ++g) {
            const int f = fbase + 8 * g + 4 * hh;
            const u32x2 rb = *(const GAS u32x2*)(res + f); const f32x4 gg = *(const GAS f32x4*)(gate + f);
            o[4 * g] = bflo(rb.x) + gg.x * acc[4 * g]; o[4 * g + 1] = bfhi(rb.x) + gg.y * acc[4 * g + 1]; o[4 * g + 2] = bflo(rb.y) + gg.z * acc[4 * g + 2]; o[4 * g + 3] = bfhi(rb.y) + gg.w * acc[4 * g + 3];
        }
        store_bf16_row32(x2b + (size_t)t * D + fbase, o, hh);
    }
};

struct EpiBin {
    bf16_t* cq; bf16_t* ckv; float* ssq; unsigned char* kv; const f32x2* ropeB; bf16_t* sg;
    DI void operator()(int fbase, int tbase, const f32x16& acc, int r, int hh) const {
        const int t = tbase + r;
        if (fbase < 384) {
            float o[16]; float s = 0.f;
#pragma unroll
            for (int i = 0; i < 16; ++i) { o[i] = acc[i]; s += acc[i] * acc[i]; }
            s += __shfl_xor(s, 32);
            if (fbase < 256) { store_bf16_row32(cq + (size_t)t * 256 + fbase, o, hh); if (hh == 0) atomicAdd(ssq + t, s); }
            else { store_bf16_row32(ckv + (size_t)t * 128 + (fbase - 256), o, hh); if (hh == 0) atomicAdd(ssq + MTOT + t, s); }
        } else if (fbase < 416) {
            float o[16];
            int b, key;
            if (t < MLAT) {
                b = t >> 13; key = t & (SEQ - 1);
                const f32x2* tr = ropeB + (key >> 6) * 8 + 4 * hh;
                const f32x2* tc = ropeB + (key & 63) * 8 + 4 * hh;
#pragma unroll
                for (int i = 0; i < 4; ++i) {
                    const f32x2 c1 = tr[i]; const float a = acc[i], b2 = acc[i + 4];
                    o[i] = a * c1.x - b2 * c1.y; o[i + 4] = b2 * c1.x + a * c1.y;
                    const f32x2 c2 = tc[i]; const float a2 = acc[i + 8], b3 = acc[i + 12];
                    o[i + 8] = a2 * c2.x - b3 * c2.y; o[i + 12] = b3 * c2.x + a2 * c2.y;
                }
            } else {
                const int tc2 = t - MLAT; b = tc2 >> 8; key = SEQ + (tc2 & 255);
#pragma unroll
                for (int i = 0; i < 16; ++i) o[i] = acc[i];
            }
            unsigned char* base = kv + ((size_t)(b * 16) * KV_NT + (key >> 6)) * KV_TILE_BYTES + (key & 63) * KROW + 128;
#pragma unroll
            for (int p = 0; p < 2; ++p) {
                unsigned ax = pk2(o[8 * p + 0], o[8 * p + 1]), ay = pk2(o[8 * p + 2], o[8 * p + 3]);
                unsigned bx = pk2(o[8 * p + 4], o[8 * p + 5]), by = pk2(o[8 * p + 6], o[8 * p + 7]);
                const auto rx = __builtin_amdgcn_permlane32_swap(ax, bx, false, false);
                const auto ry = __builtin_amdgcn_permlane32_swap(ay, by, false, false);
                u32x4 wv; wv.x = rx[0]; wv.y = ry[0]; wv.z = rx[1]; wv.w = ry[1];
#pragma unroll
                for (int hd = 0; hd < 16; ++hd) *(GAS u32x4*)(base + (size_t)hd * KV_NT * KV_TILE_BYTES + (16 * p + 8 * hh) * 2) = wv;
            }
        } else if (fbase < 1440) {
            float o[16];
#pragma unroll
            for (int i = 0; i < 16; ++i) o[i] = silu_f(acc[i]);
            store_bf16_row32(sg + (size_t)t * 1024 + (fbase - 416), o, hh);
        }
    }
};

struct EpiUq {
    bf16_t* q1; const f32x2* ropeB; const float* ssq;
    DI void operator()(int fbase, int tbase, const f32x16& acc, int r, int hh) const {
        const int t = tbase + r;
        f32x16 v = acc;
        if (((fbase >> 5) % 3) == 2) {
            const int pos = t & (SEQ - 1);
            const f32x2* tr = ropeB + (pos >> 6) * 8 + 4 * hh;
            const f32x2* tc = ropeB + (pos & 63) * 8 + 4 * hh;
#pragma unroll
            for (int i = 0; i < 4; ++i) {
                const f32x2 c1 = tr[i]; const float a = acc[i], b = acc[i + 4];
                v[i] = a * c1.x - b * c1.y; v[i + 4] = b * c1.x + a * c1.y;
                const f32x2 c2 = tc[i]; const float a2 = acc[i + 8], b2 = acc[i + 12];
                v[i + 8] = a2 * c2.x - b2 * c2.y; v[i + 12] = b2 * c2.x + a2 * c2.y;
            }
        }
        const float rs = QSCALE_B / sqrtf(ssq[t] * (1.f / 256.f) + EPS);
        float o[16];
#pragma unroll
        for (int i = 0; i < 16; ++i) o[i] = v[i] * rs;
        store_bf16_row32(q1 + (size_t)t * 1536 + fbase, o, hh);
    }
};

struct EpiUkv {
    unsigned char* kv; unsigned char* patch; const float* ssq;
    DI void operator()(int fbase, int tbase, const f32x16& acc, int r, int hh) const {
        const int t = tbase + r;
        const int head = fbase >> 7, dd0 = fbase & 127;
        int b, key;
        if (t < MLAT) { b = t >> 13; key = t & (SEQ - 1); } else { const int tc = t - MLAT; b = tc >> 8; key = SEQ + (tc & 255); }
        unsigned char* base = kv + ((size_t)(b * 16 + head) * KV_NT + (key >> 6)) * KV_TILE_BYTES;
        const int kin = key & 63;
        const float rs = 1.f / sqrtf(ssq[MTOT + t] * (1.f / 128.f) + EPS);
        if (dd0 < 64) {
            float o[16];
#pragma unroll
            for (int i = 0; i < 16; ++i) o[i] = acc[i] * rs;
            store_bf16_row32((bf16_t*)(base + kin * KROW) + dd0, o, hh);
        } else {
            f32x16 sv = acc * rs;
            store_bf16_tr32((bf16_t*)(base + KV_VOFF + (dd0 - 64) * 144) + (kin - r), 72, sv, patch, r, hh);
        }
    }
};

DI void prep_b_phase(const Params& p, unsigned char* ws, int tid) {
    const int lane = tid & 63, gw = blockIdx.x * 8 + (tid >> 6), ngw = gridDim.x * 8;
    const float* c416 = (const float*)(ws + WS_C416);
    bf16_t* cqn = (bf16_t*)(ws + WS_CQN);
    bf16_t* ckvn = (bf16_t*)(ws + WS_CKVN);
    const f32x2* ropeB = (const f32x2*)(ws + WS_ROPEB);
    const float* qg = p.in[14]; const float* kvg = p.in[16];
    for (int t = gw; t < MTOT; t += ngw) {
        const float* c = c416 + (size_t)t * 416;
        const f32x4 a = *(const f32x4*)(c + lane * 4);
        const float s1 = wave_sum((a.x * a.x + a.y * a.y) + (a.z * a.z + a.w * a.w));
        const float r1 = 1.f / sqrtf(s1 * (1.f / 256.f) + EPS);
        const f32x4 g1 = *(const f32x4*)(qg + lane * 4);
        store_bf16x4(cqn + (size_t)t * 256 + lane * 4, a.x * r1 * g1.x, a.y * r1 * g1.y, a.z * r1 * g1.z, a.w * r1 * g1.w);
        const f32x2 bq = *(const f32x2*)(c + 256 + lane * 2);
        const float s2 = wave_sum(bq.x * bq.x + bq.y * bq.y);
        const float r2 = 1.f / sqrtf(s2 * (1.f / 128.f) + EPS);
        const f32x2 g2 = *(const f32x2*)(kvg + lane * 2);
        *(unsigned*)(ckvn + (size_t)t * 128 + lane * 2) = pk2(bq.x * r2 * g2.x, bq.y * r2 * g2.y);
        {
            const int hd = lane >> 2, cc = lane & 3;
            const f32x4 xa = *(const GAS f32x4*)(c + 384 + 8 * cc), xb = *(const GAS f32x4*)(c + 384 + 8 * cc + 4);
            const f32x4 ya = *(const GAS f32x4*)(c + 384 + 8 * (cc ^ 1)), yb = *(const GAS f32x4*)(c + 384 + 8 * (cc ^ 1) + 4);
            float xo[8] = {xa.x, xa.y, xa.z, xa.w, xb.x, xb.y, xb.z, xb.w};
            const float yo[8] = {ya.x, ya.y, ya.z, ya.w, yb.x, yb.y, yb.z, yb.w};
            int b, key;
            if (t < MLAT) {
                b = t >> 13; key = t & (SEQ - 1);
                const int pp = (cc < 2) ? (key >> 6) : (key & 63);
                const float sgn = (cc & 1) ? 1.f : -1.f;
#pragma unroll
                for (int j = 0; j < 8; ++j) { const f32x2 cs = ropeB[pp * 8 + j]; xo[j] = xo[j] * cs.x + sgn * yo[j] * cs.y; }
            } else { const int tc = t - MLAT; b = tc >> 8; key = SEQ + (tc & 255); }
            u32x4 wv; wv.x = pk2(xo[0], xo[1]); wv.y = pk2(xo[2], xo[3]); wv.z = pk2(xo[4], xo[5]); wv.w = pk2(xo[6], xo[7]);
            unsigned char* dst = ws + WS_KV + ((size_t)(b * 16 + hd) * KV_NT + (key >> 6)) * KV_TILE_BYTES + (key & 63) * KROW + (64 + 8 * cc) * 2;
            *(GAS u32x4*)dst = wv;
        }
    }
}

DI float max3f_(float a, float b, float c) { return fmaxf(fmaxf(a, b), c); }
DI void softmax_pv(f32x16 (&S)[2], f32x16 (&O)[2], float& m, float& l, const unsigned char* vl, int r, int hh) {
    float e[2][16];
    float lt = 0.f;
#pragma unroll
    for (int sb = 0; sb < 2; ++sb)
#pragma unroll
        for (int i = 0; i < 16; ++i) { e[sb][i] = ex2(S[sb][i] - m); lt += e[sb][i]; }
    if (__any(!(lt <= 1.0995116e12f))) {
        float mx = max3f_(S[0][0], S[0][1], S[0][2]);
#pragma unroll
        for (int i = 3; i < 15; i += 2) mx = max3f_(mx, S[0][i], S[0][i + 1]);
        mx = max3f_(mx, S[0][15], S[1][0]);
#pragma unroll
        for (int i = 1; i < 15; i += 2) mx = max3f_(mx, S[1][i], S[1][i + 1]);
        mx = fmaxf(mx, S[1][15]);
        mx = fmaxf(mx, __shfl_xor(mx, 32));
        const float mn = fmaxf(m, mx), alpha = ex2(m - mn);
        m = mn; l *= alpha; lt = 0.f;
#pragma unroll
        for (int i = 0; i < 16; ++i) { O[0][i] *= alpha; O[1][i] *= alpha; }
#pragma unroll
        for (int sb = 0; sb < 2; ++sb)
#pragma unroll
            for (int i = 0; i < 16; ++i) { e[sb][i] = ex2(S[sb][i] - mn); lt += e[sb][i]; }
    }
    l += lt;
#pragma unroll
    for (int sb = 0; sb < 2; ++sb)
#pragma unroll
        for (int s = 0; s < 2; ++s) {
            u32x4 pw;
            pw.x = pk2(e[sb][8 * s + 0], e[sb][8 * s + 1]); pw.y = pk2(e[sb][8 * s + 2], e[sb][8 * s + 3]);
            pw.z = pk2(e[sb][8 * s + 4], e[sb][8 * s + 5]); pw.w = pk2(e[sb][8 * s + 6], e[sb][8 * s + 7]);
            const bf16x8 pf = __builtin_bit_cast(bf16x8, pw);
#pragma unroll
            for (int db = 0; db < 2; ++db) {
                const bf16x8 vf = *(const bf16x8*)(vl + (db * 32 + r) * 144 + (sb * 32 + s * 16 + hh * 8) * 2);
                O[db] = MFMA(vf, pf, O[db]);
            }
        }
}

DI void attn_store(const f32x16 (&O)[2], float l, const bf16_t* sg, bf16_t* og, size_t rowoff, int hh) {
    const float lt = l + __shfl_xor(l, 32);
    const float inv = 1.f / lt;
#pragma unroll
    for (int db = 0; db < 2; ++db) {
        float o[16];
#pragma unroll
        for (int g = 0; g < 4; ++g) {
            const size_t idx = rowoff + db * 32 + 8 * g + 4 * hh;
            const u32x2 sv = *(const GAS u32x2*)(sg + idx);
            o[4 * g] = O[db][4 * g] * inv * bflo(sv.x); o[4 * g + 1] = O[db][4 * g + 1] * inv * bfhi(sv.x);
            o[4 * g + 2] = O[db][4 * g + 2] * inv * bflo(sv.y); o[4 * g + 3] = O[db][4 * g + 3] * inv * bfhi(sv.y);
        }
        store_bf16_row32(og + rowoff + db * 32, o, hh);
    }
}

DI void attn_a_phase(const Params& p, unsigned char* ws, unsigned char* lds, int tid) {
    const int lane = tid & 63, w = tid >> 6, r = lane & 31, hh = lane >> 5;
    const int pr = (r & ~12) | ((r & 4) << 1) | ((r & 8) >> 1);
    const int qs = w & 3, hp = w >> 2;
    const bf16_t* q0 = (const bf16_t*)(ws + WS_Q0);
    const bf16_t* k0 = (const bf16_t*)(ws + WS_K0);
    const bf16_t* vt0 = (const bf16_t*)(ws + WS_VT0);
    const bf16_t* sg = (const bf16_t*)(ws + WS_SG);
    bf16_t* og = (bf16_t*)(ws + WS_OG0);
    const float* sinks = p.in[8];
    const int lrow = tid >> 3, lch = tid & 7;
    for (int round = 0;; ++round) {
        int u;
        if (gridDim.x == 256) {
            const int j = blockIdx.x;
            if (round == 0) u = j; else if (round == 1) u = (j < 16) ? 496 + j : 240 + j; else if (round == 2 && j < 16) u = 512 + j; else break;
        } else { u = blockIdx.x + round * gridDim.x; if (u >= 528) break; }
        int b, kvh, iblk, tq0, ntiles, ploc0;
        bool latent;
        if (u < 512) {
            latent = true;
            if (u < 496) { b = u / 248; const int rem = u % 248; iblk = 1 + (rem >> 2); kvh = rem & 3; }
            else { const int li = u - 496; b = li >> 3; iblk = ((li >> 2) & 1) ? 63 : 0; kvh = li & 3; }
            tq0 = b * SEQ + iblk * 128 + qs * 32;
            ploc0 = (iblk > 0) ? (iblk - 1) * 128 : 0; const int pend = (iblk < 63) ? (iblk + 2) * 128 : SEQ; ntiles = 4 + ((pend - ploc0) >> 6); }
        else { const int uc = u - 512; latent = false; b = uc >> 3; iblk = 0; kvh = uc & 3; tq0 = MLAT + b * CTX + ((uc >> 2) & 1) * 128 + qs * 32; ploc0 = 0; ntiles = 4; }
        const int hd0 = kvh * 4 + hp * 2;
        bf16x8 qf[2][4];
#pragma unroll
        for (int e = 0; e < 2; ++e)
#pragma unroll
            for (int ks = 0; ks < 4; ++ks) qf[e][ks] = *(const bf16x8*)(q0 + (size_t)(tq0 + r) * 1024 + (hd0 + e) * 64 + ks * 16 + hh * 8);
        f32x16 O[2][2];
        float m[2], l[2];
#pragma unroll
        for (int e = 0; e < 2; ++e) {
            m[e] = sinks[hd0 + e] * LOG2E; l[e] = hh ? 0.f : 1.f;
#pragma unroll
            for (int i = 0; i < 16; ++i) { O[e][0][i] = 0.f; O[e][1][i] = 0.f; }
        }
        const int qlo = iblk * 128 + qs * 32;
        u32x4 rk, rv;
#define A_LOAD(ti_)                                                                                             \
    {                                                                                                           \
        int ktok0_, vkey0_;                                                                                     \
        if ((ti_) < 4) { ktok0_ = MLAT + b * CTX + (ti_) * 64; vkey0_ = SEQ + (ti_) * 64; }                     \
        else { const int p0_ = ploc0 + ((ti_) - 4) * 64; ktok0_ = b * SEQ + p0_; vkey0_ = p0_; }                \
        rk = *(const GAS u32x4*)(const void*)(k0 + (size_t)(ktok0_ + lrow) * 256 + kvh * 64 + lch * 8);        \
        rv = *(const GAS u32x4*)(const void*)(vt0 + (size_t)(b * 256 + kvh * 64 + lrow) * KVKEYS + vkey0_ + lch * 8); \
    }
#define A_STORE(st_)                                                                                            \
    {                                                                                                           \
        unsigned char* sb_ = lds + (st_) * 18432 + lrow * 144 + lch * 16;                                       \
        *(u32x4*)sb_ = rk; *(u32x4*)(sb_ + 9216) = rv;                                                          \
    }
        A_LOAD(0);
        A_STORE(0);
        __syncthreads();
        for (int ti = 0; ti < ntiles; ++ti) {
            if (ti + 1 < ntiles) { A_LOAD(ti + 1); }
            const unsigned char* kl = lds + (ti & 1) * 18432;
            const unsigned char* vl = kl + 9216;
            const bool masked = ti >= 4;
            const int kpos0 = ploc0 + (ti - 4) * 64;
            const bool skip = masked && (kpos0 > qlo + 31 + 128 || kpos0 + 63 < qlo - 128);
            if (!skip) {
                f32x16 S[2][2];
#pragma unroll
                for (int e = 0; e < 2; ++e)
#pragma unroll
                    for (int sb = 0; sb < 2; ++sb)
#pragma unroll
                        for (int i = 0; i < 16; ++i) S[e][sb][i] = 0.f;
#pragma unroll
                for (int sb = 0; sb < 2; ++sb)
#pragma unroll
                    for (int ks = 0; ks < 4; ++ks) {
                        const bf16x8 kf = *(const bf16x8*)(kl + (sb * 32 + pr) * 144 + ks * 32 + hh * 16);
                        S[0][sb] = MFMA(kf, qf[0][ks], S[0][sb]);
                        S[1][sb] = MFMA(kf, qf[1][ks], S[1][sb]);
                    }
                if (masked && !(kpos0 >= qlo - 97 && kpos0 <= qlo + 65)) {
                    const int qp = qlo + r;
#pragma unroll
                    for (int sb = 0; sb < 2; ++sb)
#pragma unroll
                        for (int i = 0; i < 16; ++i) {
                            const int kp = kpos0 + sb * 32 + 16 * (i >> 3) + 8 * hh + (i & 7);
                            const int dlt = qp - kp;
                            if (dlt > 128 || dlt < -128) { S[0][sb][i] = -1e30f; S[1][sb][i] = -1e30f; }
                        }
                }
                softmax_pv(S[0], O[0], m[0], l[0], vl, r, hh);
                softmax_pv(S[1], O[1], m[1], l[1], vl, r, hh);
            }
            if (ti + 1 < ntiles) { A_STORE((ti + 1) & 1); }
            __syncthreads();
        }
#undef A_LOAD
#undef A_STORE
        (void)latent;
#pragma unroll
        for (int e = 0; e < 2; ++e) attn_store(O[e], l[e], sg, og, (size_t)(tq0 + r) * 1024 + (hd0 + e) * 64, hh);
    }
}

DI float max3f(float a, float b, float c) { return fmaxf(fmaxf(a, b), c); }
constexpr float DEFER_THR = 8.f;
constexpr int BK_OFF0 = 0, BV_OFF0 = 2 * KV_VOFF, BV_SZ = 64 * 144;
template <int MODE>
DI void attn_b_phase(unsigned char* ws, unsigned char* lds, int tid) {
    const int lane = tid & 63, w = tid >> 6, r = lane & 31, hh = lane >> 5;
    const int pr = (r & ~12) | ((r & 4) << 1) | ((r & 8) >> 1);
    const bf16_t* q1 = (const bf16_t*)(ws + WS_Q1);
    const bf16_t* sg = (const bf16_t*)(ws + WS_SG);
    bf16_t* og = (bf16_t*)(ws + WS_H);
    const int wu = __builtin_amdgcn_readfirstlane(w);
    const u32x4 konev = {hh ? 0u : 0x3F80u, 0u, 0u, 0u};
    const bf16x8 kone = __builtin_bit_cast(bf16x8, konev);
    const unsigned koff = pr * KROW + hh * 16;
    const unsigned voff = r * 144 + hh * 16;
    if (wu >= 4) __builtin_amdgcn_s_setprio(1);
    bool staged = false;
    for (int it = 0;; ++it) {
        const int u = blockIdx.x + it * gridDim.x;
        if (u >= 1024) break;
        int bh, qt;
        if (gridDim.x == 256) { bh = it * 8 + (blockIdx.x & 7); qt = blockIdx.x >> 3; } else { bh = u >> 5; qt = u & 31; }
        const int b = bh >> 4, h = bh & 15;
        const int t0 = b * SEQ + qt * 256 + w * 32;
        bf16x8 qf[6];
#pragma unroll
        for (int ks = 0; ks < 6; ++ks) qf[ks] = *(const bf16x8*)(q1 + (size_t)(t0 + r) * 1536 + h * 96 + ks * 16 + hh * 8);
        f32x16 O[2];
#pragma unroll
        for (int i = 0; i < 16; ++i) { O[0][i] = 0.f; O[1][i] = 0.f; }
        float m = 0.f, l = 0.f;
        unsigned q6 = 0u;
        bool refnz = false;
        const GAS unsigned char* kvb = (const GAS unsigned char*)(ws + WS_KV + (size_t)bh * KV_NT * KV_TILE_BYTES);
        const bool has_next = u + (int)gridDim.x < 1024;
        const int bh_next = has_next ? ((gridDim.x == 256) ? (it + 1) * 8 + (blockIdx.x & 7) : (u + (int)gridDim.x) >> 5) : bh;
        const GAS unsigned char* kvn = (const GAS unsigned char*)(ws + WS_KV + (size_t)bh_next * KV_NT * KV_TILE_BYTES);
#define B_DMAP(kp_, vp_, ko_, vo_)     \
    {                                                                                                 \
        const GAS unsigned char* sk_ = (kp_) + lane * 16;                                             \
        const GAS unsigned char* sv_ = (vp_) + lane * 16;                                             \
        const GAS unsigned char* s1_ = (wu < 7) ? sk_ + (8 + wu) * 1024 : sv_ + 15 * 1024;            \
        const unsigned d1_ = (wu < 7) ? (ko_) + (8 + wu) * 1024 : (vo_);                              \
        __builtin_amdgcn_global_load_lds((const GAS unsigned*)(sk_ + wu * 1024), (LAS unsigned*)(lds + (ko_) + wu * 1024), 16, 0, 0); \
        __builtin_amdgcn_global_load_lds((const GAS unsigned*)s1_, (LAS unsigned*)(lds + d1_), 16, 0, 0); \
        __builtin_amdgcn_global_load_lds((const GAS unsigned*)(sv_ + (16 + wu) * 1024), (LAS unsigned*)(lds + (vo_) + (1 + wu) * 1024), 16, 0, 0); \
    }
#define B_DMA(kt_, vt_, ko_, vo_) B_DMAP(kvb + (size_t)(kt_) * KV_TILE_BYTES, kvb + (size_t)(vt_) * KV_TILE_BYTES, ko_, vo_)
#define B_BARRIER() { if (MODE != 4) { asm volatile("s_waitcnt vmcnt(0) lgkmcnt(0)" ::: "memory"); __builtin_amdgcn_s_barrier(); asm volatile("" ::: "memory"); } }
#define B_QK(S_, ko_)                                                                                 \
    {                                                                                                 \
        const unsigned char* kl_ = lds + (ko_) + koff;                                                \
        u32x4 q6v_ = {q6, 0u, 0u, 0u};                                                                \
        const bf16x8 q6f_ = __builtin_bit_cast(bf16x8, q6v_);                                         \
        _Pragma("unroll") for (int sb = 0; sb < 2; ++sb) {                                            \
            _Pragma("unroll") for (int i = 0; i < 16; ++i) S_[sb][i] = 0.f;                           \
            _Pragma("unroll") for (int ks = 0; ks < 6; ++ks) {                                        \
                const bf16x8 kf_ = *(const bf16x8*)(kl_ + sb * 32 * KROW + ks * 32);                  \
                S_[sb] = MFMA(kf_, qf[ks], S_[sb]);                                                   \
            }                                                                                         \
            S_[sb] = MFMA(kone, q6f_, S_[sb]);                                                        \
        }                                                                                             \
    }
#define B_PV(vo_)                                                                                     \
    {                                                                                                 \
        const unsigned char* vl_ = lds + (vo_) + voff;                                                \
        _Pragma("unroll") for (int sb = 0; sb < 2; ++sb)                                              \
            _Pragma("unroll") for (int s = 0; s < 2; ++s) {                                           \
                const bf16x8 pf_ = __builtin_bit_cast(bf16x8, pw[sb][s]);                             \
                _Pragma("unroll") for (int db = 0; db < 2; ++db) {                                    \
                    const bf16x8 vf_ = (MODE == 5) ? qf[sb * 2 + s] : *(const bf16x8*)(vl_ + db * 32 * 144 + (sb * 32 + s * 16) * 2); \
                    O[db] = MFMA(vf_, pf_, O[db]);                                                    \
                }                                                                                     \
            }                                                                                         \
    }
        if (!staged) {
            B_DMA(0, 0, BK_OFF0, BV_OFF0);
            B_DMA(1, 1, KV_VOFF, BV_OFF0 + BV_SZ);
            { const u32x4 z = {0u, 0u, 0u, 0u}; *(u32x4*)(lds + BV_OFF0 + 2 * BV_SZ + tid * 16) = z; if (tid < 64) *(u32x4*)(lds + BV_OFF0 + 2 * BV_SZ + 8192 + tid * 16) = z; }
            B_BARRIER();
        }
        f32x16 S0[2], S1[2];
        B_QK(S0, BK_OFF0);
        B_BARRIER();
        u32x4 pw[2][2];
#pragma unroll
        for (int sb = 0; sb < 2; ++sb)
#pragma unroll
            for (int s = 0; s < 2; ++s) pw[sb][s] = (u32x4){0u, 0u, 0u, 0u};
        unsigned kcur = BK_OFF0, knext = KV_VOFF;
        unsigned vprev = BV_OFF0 + 2 * BV_SZ, vcur = BV_OFF0, vnext = BV_OFF0 + BV_SZ;
#define B_UNIT(Sa_, j_)                                                                               \
    if (MODE != 3 && MODE != 4) {                                                                     \
        const float e0_ = ex2(Sa_[(j_) >> 3][2 * ((j_) & 7)]), e1_ = ex2(Sa_[(j_) >> 3][2 * ((j_) & 7) + 1]); \
        lt_ += e0_; lt_ += e1_;                                                                       \
        pw[(j_) >> 3][((j_) >> 2) & 1][(j_) & 3] = pk2(e0_, e1_);                                     \
    }
#define B_KFRAG(g_, NKS_) ((MODE == 5) ? qf[(g_) % 6] : (((g_) % (NKS_)) < 6 ? *(const bf16x8*)(kl_ + ((g_) / (NKS_)) * 32 * KROW + ((g_) % (NKS_)) * 32) : kone))
#define B_CHUNK(Sb_, g_, NKS_, kf_)                                                                   \
    {                                                                                                 \
        if (((g_) % (NKS_)) == 0) { _Pragma("unroll") for (int i = 0; i < 16; ++i) Sb_[(g_) / (NKS_)][i] = 0.f; } \
        Sb_[(g_) / (NKS_)] = MFMA(kf_, (((g_) % (NKS_)) < 6 ? qf[((g_) % (NKS_)) < 6 ? ((g_) % (NKS_)) : 0] : q6f_), Sb_[(g_) / (NKS_)]); \
        if ((g_) + 3 < 2 * (NKS_)) kf_ = B_KFRAG((g_) + 3, NKS_);                                     \
    }
#define B_ITER(Sa_, Sb_, kt_)                                                                         \
    {                                                                                                 \
        if (MODE < 2) {                                                                               \
            const GAS unsigned char* kp_ = ((kt_) + 2 < KV_NT) ? kvb + (size_t)((kt_) + 2) * KV_TILE_BYTES : kvn + (size_t)((kt_) + 2 - KV_NT) * KV_TILE_BYTES; \
            const GAS unsigned char* vp_ = ((kt_) + 1 < KV_NT) ? kvb + (size_t)((kt_) + 1) * KV_TILE_BYTES : kvn;                                           \
            B_DMAP(kp_, vp_, kcur, vnext);                                                            \
        }                                                                                             \
        if (MODE != 1) {                                                                              \
                                                                                      \
        B_PV(vprev);                                                                                  \
          \
        float mx = 0.f;                                                                               \
        if ((kt_) == 0 && MODE != 3 && MODE != 4) {                                                   \
        mx = max3f(Sa_[0][0], Sa_[0][1], Sa_[0][2]);                                                  \
        _Pragma("unroll") for (int i = 3; i < 15; i += 2) mx = max3f(mx, Sa_[0][i], Sa_[0][i + 1]);   \
        mx = max3f(mx, Sa_[0][15], Sa_[1][0]);                                                        \
        _Pragma("unroll") for (int i = 1; i < 15; i += 2) mx = max3f(mx, Sa_[1][i], Sa_[1][i + 1]);   \
        mx = fmaxf(mx, Sa_[1][15]);                                                                   \
        mx = fmaxf(mx, __shfl_xor(mx, 32));                                                           \
        }                                                                                             \
        if ((kt_) == 0 && __any((mx > DEFER_THR) || (mx < -DEFER_THR))) {                             \
            const float mnew = bflo(pk2(m + mx, 0.f) & 0xffffu);                                      \
            const float delta = mnew - m;                                                             \
            const float alpha = ex2(-delta);                                                          \
            m = mnew; l *= alpha;                                                                     \
            q6 = hh ? 0u : (pk2(-mnew, 0.f) & 0xffffu);                                               \
            refnz = refnz || __any(mnew != 0.f);                                                      \
            _Pragma("unroll") for (int i = 0; i < 16; ++i) { O[0][i] *= alpha; O[1][i] *= alpha; Sa_[0][i] -= delta; Sa_[1][i] -= delta; } \
        }                                                                                             \
           \
        float lt_ = 0.f;                                                                              \
        {                                                                                             \
            const unsigned char* kl_ = lds + knext + koff;                                            \
            u32x4 q6v_ = {q6, 0u, 0u, 0u};                                                            \
            const bf16x8 q6f_ = __builtin_bit_cast(bf16x8, q6v_);                                     \
            if (refnz) { \
            { bf16x8 kfa_ = B_KFRAG(0, 7), kfb_ = B_KFRAG(1, 7), kfc_ = B_KFRAG(2, 7); \
            B_CHUNK(Sb_, 0, 7, kfa_) B_UNIT(Sa_, 0) B_UNIT(Sa_, 1) __builtin_amdgcn_sched_barrier(0); \
            B_CHUNK(Sb_, 1, 7, kfb_) B_UNIT(Sa_, 2) B_UNIT(Sa_, 3) __builtin_amdgcn_sched_barrier(0); \
            B_CHUNK(Sb_, 2, 7, kfc_) B_UNIT(Sa_, 4) __builtin_amdgcn_sched_barrier(0); \
            B_CHUNK(Sb_, 3, 7, kfa_) B_UNIT(Sa_, 5) __builtin_amdgcn_sched_barrier(0); \
            B_CHUNK(Sb_, 4, 7, kfb_) B_UNIT(Sa_, 6) __builtin_amdgcn_sched_barrier(0); \
            B_CHUNK(Sb_, 5, 7, kfc_) B_UNIT(Sa_, 7) __builtin_amdgcn_sched_barrier(0); \
            B_CHUNK(Sb_, 6, 7, kfa_) B_UNIT(Sa_, 8) __builtin_amdgcn_sched_barrier(0); \
            B_CHUNK(Sb_, 7, 7, kfb_) B_UNIT(Sa_, 9) __builtin_amdgcn_sched_barrier(0); \
            B_CHUNK(Sb_, 8, 7, kfc_) B_UNIT(Sa_, 10) __builtin_amdgcn_sched_barrier(0); \
            B_CHUNK(Sb_, 9, 7, kfa_) B_UNIT(Sa_, 11) __builtin_amdgcn_sched_barrier(0); \
            B_CHUNK(Sb_, 10, 7, kfb_) B_UNIT(Sa_, 12) __builtin_amdgcn_sched_barrier(0); \
            B_CHUNK(Sb_, 11, 7, kfc_) B_UNIT(Sa_, 13) __builtin_amdgcn_sched_barrier(0); \
            B_CHUNK(Sb_, 12, 7, kfa_) B_UNIT(Sa_, 14) __builtin_amdgcn_sched_barrier(0); \
            B_CHUNK(Sb_, 13, 7, kfb_) B_UNIT(Sa_, 15) __builtin_amdgcn_sched_barrier(0); \
            } \
            } else { \
            { bf16x8 kfa_ = B_KFRAG(0, 6), kfb_ = B_KFRAG(1, 6), kfc_ = B_KFRAG(2, 6); \
            B_CHUNK(Sb_, 0, 6, kfa_) B_UNIT(Sa_, 0) B_UNIT(Sa_, 1) __builtin_amdgcn_sched_barrier(0); \
            B_CHUNK(Sb_, 1, 6, kfb_) B_UNIT(Sa_, 2) B_UNIT(Sa_, 3) __builtin_amdgcn_sched_barrier(0); \
            B_CHUNK(Sb_, 2, 6, kfc_) B_UNIT(Sa_, 4) B_UNIT(Sa_, 5) __builtin_amdgcn_sched_barrier(0); \
            B_CHUNK(Sb_, 3, 6, kfa_) B_UNIT(Sa_, 6) B_UNIT(Sa_, 7) __builtin_amdgcn_sched_barrier(0); \
            B_CHUNK(Sb_, 4, 6, kfb_) B_UNIT(Sa_, 8) __builtin_amdgcn_sched_barrier(0); \
            B_CHUNK(Sb_, 5, 6, kfc_) B_UNIT(Sa_, 9) __builtin_amdgcn_sched_barrier(0); \
            B_CHUNK(Sb_, 6, 6, kfa_) B_UNIT(Sa_, 10) __builtin_amdgcn_sched_barrier(0); \
            B_CHUNK(Sb_, 7, 6, kfb_) B_UNIT(Sa_, 11) __builtin_amdgcn_sched_barrier(0); \
            B_CHUNK(Sb_, 8, 6, kfc_) B_UNIT(Sa_, 12) __builtin_amdgcn_sched_barrier(0); \
            B_CHUNK(Sb_, 9, 6, kfa_) B_UNIT(Sa_, 13) __builtin_amdgcn_sched_barrier(0); \
            B_CHUNK(Sb_, 10, 6, kfb_) B_UNIT(Sa_, 14) __builtin_amdgcn_sched_barrier(0); \
            B_CHUNK(Sb_, 11, 6, kfc_) B_UNIT(Sa_, 15) __builtin_amdgcn_sched_barrier(0); \
            } \
            } \
        }                                                                                             \
          \
        if (MODE != 3 && MODE != 4 && __any(!(lt_ <= 1.0995116e12f))) {                                \
            float mx2 = max3f(Sa_[0][0], Sa_[0][1], Sa_[0][2]);                                       \
            _Pragma("unroll") for (int i = 3; i < 15; i += 2) mx2 = max3f(mx2, Sa_[0][i], Sa_[0][i + 1]); \
            mx2 = max3f(mx2, Sa_[0][15], Sa_[1][0]);                                                   \
            _Pragma("unroll") for (int i = 1; i < 15; i += 2) mx2 = max3f(mx2, Sa_[1][i], Sa_[1][i + 1]); \
            mx2 = fmaxf(mx2, Sa_[1][15]);                                                             \
            mx2 = fmaxf(mx2, __shfl_xor(mx2, 32));                                                    \
            const float mnew = bflo(pk2(m + mx2, 0.f) & 0xffffu);                                     \
            const float delta = mnew - m;                                                             \
            const float alpha = ex2(-delta);                                                          \
            m = mnew; l *= alpha;                                                                     \
            q6 = hh ? 0u : (pk2(-mnew, 0.f) & 0xffffu);                                               \
            refnz = refnz || __any(mnew != 0.f);                                                      \
            lt_ = 0.f;                                                                                \
            _Pragma("unroll") for (int i = 0; i < 16; ++i) { O[0][i] *= alpha; O[1][i] *= alpha; Sb_[0][i] -= delta; Sb_[1][i] -= delta; } \
            _Pragma("unroll") for (int j = 0; j < 16; ++j) {                                          \
                const float e0_ = ex2(Sa_[j >> 3][2 * (j & 7)] - delta), e1_ = ex2(Sa_[j >> 3][2 * (j & 7) + 1] - delta); \
                lt_ += e0_; lt_ += e1_;                                                               \
                pw[j >> 3][(j >> 2) & 1][j & 3] = pk2(e0_, e1_);                                      \
            }                                                                                         \
        }                                                                                             \
        l += lt_;                                                                                     \
        }                                                                                             \
                                               \
        B_BARRIER(); \
        { const unsigned t_ = kcur; kcur = knext; knext = t_; }                                       \
        { const unsigned t_ = vprev; vprev = vcur; vcur = vnext; vnext = t_; }                        \
    }
        for (int kt = 0; kt < KV_NT; kt += 2) {
            B_ITER(S0, S1, kt)
            B_ITER(S1, S0, kt + 1)
        }
#undef B_ITER
#undef B_CHUNK
#undef B_KFRAG
#undef B_UNIT
        B_PV(vprev);
#undef B_DMA
#undef B_DMAP
#undef B_QK
#undef B_PV
        staged = has_next;
        if (MODE == 0) attn_store(O, l, sg, og, (size_t)(t0 + r) * 1024 + h * 64, hh);
        else { float acc_ = l + m; _Pragma("unroll") for (int i = 0; i < 16; ++i) acc_ += O[0][i] + O[1][i] + S0[0][i] + S0[1][i] + S1[0][i] + S1[1][i]; if (acc_ == 123.456f) og[0] = 0; }
        __syncthreads();
    }
    __builtin_amdgcn_s_setprio(0);
}

DI void final_norm_phase(const float* g, const bf16_t* x2b, float* out, int tid) {
    const int lane = tid & 63, gw = blockIdx.x * 8 + (tid >> 6), ngw = gridDim.x * 8;
    for (int row0 = gw; row0 < MLAT; row0 += 2 * ngw) {
        f32x4 v[2][4]; bool ok[2]; int row[2];
#pragma unroll
        for (int q = 0; q < 2; ++q) {
            row[q] = row0 + q * ngw; ok[q] = row[q] < MLAT;
            const bf16_t* src = x2b + (size_t)(ok[q] ? row[q] : row0) * D;
#pragma unroll
            for (int j = 0; j < 4; ++j) { const u32x2 b2 = *(const GAS u32x2*)(src + lane * 4 + 256 * j); v[q][j] = (f32x4){bflo(b2.x), bfhi(b2.x), bflo(b2.y), bfhi(b2.y)}; }
        }
#pragma unroll
        for (int q = 0; q < 2; ++q) {
            float ss = 0.f;
#pragma unroll
            for (int j = 0; j < 4; ++j) ss += (v[q][j].x * v[q][j].x + v[q][j].y * v[q][j].y) + (v[q][j].z * v[q][j].z + v[q][j].w * v[q][j].w);
            const float rstd = 1.f / sqrtf(wave_sum(ss) * (1.f / D) + EPS);
            if (ok[q]) {
#pragma unroll
                for (int j = 0; j < 4; ++j) { const f32x4 gg = *(const GAS f32x4*)(g + lane * 4 + 256 * j); *(GAS f32x4*)(out + (size_t)row[q] * D + lane * 4 + 256 * j) = v[q][j] * rstd * gg; }
            }
        }
    }
}

#define XB_TMO      128
#define XB_XCNT(j)  (256  + 64 * (j))
#define XB_XSUB(j)  (1280 + 64 * (j))
#define XB_XGEN(j)  (2304 + 64 * (j))
#define XB_TOP      3328
#define XB_TOPGEN   3392
#define XCD_BAR_WORDS 3456
#define XB_SPIN_CAP (1u << 18)
DI unsigned xb_ld(unsigned* p)              { return __hip_atomic_load(p, __ATOMIC_RELAXED, __HIP_MEMORY_SCOPE_AGENT); }
DI unsigned xb_add(unsigned* p, unsigned v) { return __hip_atomic_fetch_add(p, v, __ATOMIC_RELAXED, __HIP_MEMORY_SCOPE_AGENT); }
DI unsigned xb_xcc_id() { return (unsigned)__builtin_amdgcn_s_getreg((3 << 11) | 20) & 0xFu; }
#define XB_SPIN(cond, bar) do { unsigned _sp = 0; while (cond) { __builtin_amdgcn_s_sleep(1); \
    if ((++_sp & 255u) == 0u) { if (xb_ld(&(bar)[XB_TMO])) break; if (_sp > XB_SPIN_CAP) { atomicAdd(&(bar)[XB_TMO], 1u); break; } } } } while (0)
struct XcdBarrier { unsigned* bar; unsigned x; volatile LAS unsigned* st; };
DI XcdBarrier xcd_barrier_post(unsigned* bar, volatile LAS unsigned* st) {
    XcdBarrier b; b.bar = bar; b.x = xb_xcc_id(); b.st = st;
    if (threadIdx.x == 0) (void)xb_add(&bar[XB_XCNT(b.x)], 1u);
    return b;
}
DI void xcd_barrier_complete(unsigned* bar, unsigned x, unsigned& nloc, unsigned& nx) {
    const unsigned G = gridDim.x * gridDim.y * gridDim.z;
    unsigned sum, cnt, mine, sp = 0u;
    for (;;) {
        sum = 0u; cnt = 0u; mine = 0u;
#pragma unroll
        for (unsigned j = 0; j < 16; ++j) { const unsigned c = xb_ld(&bar[XB_XCNT(j)]); sum += c; cnt += (c > 0u) ? 1u : 0u; mine = (j == x) ? c : mine; }
        if (sum == G) break;
        __builtin_amdgcn_s_sleep(1);
        if ((++sp & 255u) == 0u) { if (xb_ld(&bar[XB_TMO])) break; if (sp > XB_SPIN_CAP) { atomicAdd(&bar[XB_TMO], 1u); break; } }
    }
    nloc = mine > 0u ? mine : 1u; nx = cnt > 0u ? cnt : 1u;
}
DI void xcd_barrier(const XcdBarrier& b) {
    asm volatile("s_waitcnt vmcnt(0)" ::: "memory");
    __syncthreads();
    if (threadIdx.x == 0) {
        unsigned* bar = b.bar;
        __builtin_amdgcn_s_waitcnt(0);
        unsigned nloc = b.st[0], nx = b.st[1];
        if (nloc == 0u) { xcd_barrier_complete(bar, b.x, nloc, nx); b.st[0] = nloc; b.st[1] = nx; }
        const unsigned old = xb_add(&bar[XB_XSUB(b.x)], 1u);
        const unsigned gen = old / nloc;
        if (old + 1u == (gen + 1u) * nloc) {
            __builtin_amdgcn_fence(__ATOMIC_RELEASE, "agent");
            asm volatile("s_waitcnt vmcnt(0)" ::: "memory");
            const unsigned og = xb_add(&bar[XB_TOP], 1u);
            const unsigned tg = og / nx;
            if (og + 1u == (tg + 1u) * nx) xb_add(&bar[XB_TOPGEN], 1u);
            else XB_SPIN(xb_ld(&bar[XB_TOPGEN]) == tg, bar);
            __builtin_amdgcn_fence(__ATOMIC_ACQUIRE, "agent");
            xb_add(&bar[XB_XGEN(b.x)], 1u);
            asm volatile("s_waitcnt vmcnt(0)" ::: "memory");
        } else {
            XB_SPIN(xb_ld(&bar[XB_XGEN(b.x)]) == gen, bar);
            __builtin_amdgcn_fence(__ATOMIC_ACQUIRE, "agent");
            asm volatile("s_waitcnt vmcnt(0)" ::: "memory");
        }
    }
    __syncthreads();
}

__device__ constexpr int PROBE_REP[12] = {1, 1, 1, 1, 1, 1, 1, 1, 1, 1, 1, 1};
#ifndef ONLY_PHASE
#define PH_SEL(k_) true
#else
#define PH_SEL(k_) ((k_) == ONLY_PHASE)
#endif
#define PH_BEGIN(k_) if (PH_SEL(k_) && p.ph_lo <= (k_) && (k_) < p.ph_hi) { unsigned char* ws = p.ws; float* out = p.out; int nrep_ = PROBE_REP[k_]; asm volatile("" : "+s"(ws), "+s"(out), "+s"(nrep_)); const float* mods = (const float*)(ws + WS_MODS); (void)mods; (void)out; for (int rep_ = 0; rep_ < nrep_; ++rep_) { if (rep_) __syncthreads();
#define PH_END(k_) } } if (p.ph_lo <= (k_) && (k_) + 1 < p.ph_hi) xcd_barrier(xb);
extern "C" __global__ void __launch_bounds__(512) mega_fwd(Params p) {
    extern __shared__ __attribute__((aligned(16))) unsigned char lds[];
    const int tid = threadIdx.x;
    __shared__ uint4 xb_words;
    if (tid == 0) xb_words = make_uint4(0u, 0u, 0u, 0u);
    __syncthreads();
    XcdBarrier xb; xb.bar = (unsigned*)(p.ws + WS_BAR); xb.x = 0; xb.st = (volatile LAS unsigned*)&xb_words;
    if (p.ph_hi - p.ph_lo > 1) xb = xcd_barrier_post((unsigned*)(p.ws + WS_BAR), (volatile LAS unsigned*)&xb_words);
    if (p.ph_lo < 0) cg::this_grid().sync();
    PH_BEGIN(0) phase0(p, ws, lds, tid); PH_END(0)
    PH_BEGIN(1) modulate_phase<false>(p.in[0], p.in[2], p.in[4], mods, (bf16_t*)(ws + WS_H), tid); PH_END(1)
    PH_BEGIN(2) EpiAin e{(bf16_t*)(ws + WS_Q0), (bf16_t*)(ws + WS_K0), (bf16_t*)(ws + WS_VT0), (bf16_t*)(ws + WS_SG), (const f32x2*)(ws + WS_ROPEA), lds + 65536 + (tid >> 6) * 2560};
        gemm_phase((const bf16_t*)(ws + WS_H), (const bf16_t*)(ws + WS_WT_IN0), MTOT / 256, 2560 / 256, 1024, e, lds, tid); PH_END(2)
    PH_BEGIN(3) attn_a_phase(p, ws, lds, tid); PH_END(3)
    PH_BEGIN(4) EpiWo0 e{p.in[0], (bf16_t*)out, p.in[2], (float*)(ws + WS_CTX1), mods};
        gemm_phase((const bf16_t*)(ws + WS_OG0), (const bf16_t*)(ws + WS_WT_O0), MTOT / 256, 1024 / 256, 1024, e, lds, tid); PH_END(4)
    PH_BEGIN(5) modulate_phase<true>(out, (const float*)(ws + WS_CTX1), p.in[10], mods + 3 * 3072, (bf16_t*)(ws + WS_H), tid); PH_END(5)
    PH_BEGIN(6) EpiBin e{(bf16_t*)(ws + WS_CQN), (bf16_t*)(ws + WS_CKVN), (float*)(ws + WS_SSQ), ws + WS_KV, (const f32x2*)(ws + WS_ROPEB), (bf16_t*)(ws + WS_SG)};
        gemm_phase((const bf16_t*)(ws + WS_H), (const bf16_t*)(ws + WS_WT_IN1), MTOT / 256, 1536 / 256, 1024, e, lds, tid); PH_END(6)
    PH_BEGIN(8) EpiUq e{(bf16_t*)(ws + WS_Q1), (const f32x2*)(ws + WS_ROPEB), (const float*)(ws + WS_SSQ)};
        gemm_phase((const bf16_t*)(ws + WS_CQN), (const bf16_t*)(ws + WS_WT_UQ), MLAT / 256, 1536 / 256, 256, e, lds, tid);
        EpiUkv e2{ws + WS_KV, lds + 65536 + (tid >> 6) * 2560, (const float*)(ws + WS_SSQ)};
        gemm_phase((const bf16_t*)(ws + WS_CKVN), (const bf16_t*)(ws + WS_WT_UKV), MTOT / 256, 2048 / 256, 128, e2, lds, tid); PH_END(8)
    PH_BEGIN(9) attn_b_phase<0>(ws, lds, tid); PH_END(9)
    PH_BEGIN(10) EpiWo1 e{(const bf16_t*)out, (bf16_t*)(ws + WS_Q1), mods + 3 * 3072};
        gemm_phase((const bf16_t*)(ws + WS_H), (const bf16_t*)(ws + WS_WT_O1), MLAT / 256, 1024 / 256, 1024, e, lds, tid); PH_END(10)
    PH_BEGIN(11) final_norm_phase(p.in[19], (const bf16_t*)(ws + WS_Q1), out, tid); PH_END(11)
}

extern "C" void kernel_launch(void* const* d_in, const int* in_sizes, int n_in, void* d_out, int out_size, void* d_ws, size_t ws_size, hipStream_t stream) {
    static int grid = 0;
    if (grid == 0) {
        if (n_in != 20 || ws_size < WS_END) { fprintf(stderr, "kernel_launch: unexpected n_in %d or ws_size %zu (< %zu)\n", n_in, ws_size, (size_t)WS_END); grid = -1; return; }
        int dev = 0, cus = 0, per_cu = 0;
        hipGetDevice(&dev);
        hipDeviceGetAttribute(&cus, hipDeviceAttributeMultiprocessorCount, dev);
        if (hipFuncSetAttribute((const void*)mega_fwd, hipFuncAttributeMaxDynamicSharedMemorySize, LDS_BYTES) != hipSuccess) { fprintf(stderr, "kernel_launch: hipFuncSetAttribute failed\n"); }
        if (hipOccupancyMaxActiveBlocksPerMultiprocessor(&per_cu, (const void*)mega_fwd, 512, LDS_BYTES) != hipSuccess || per_cu < 1) { fprintf(stderr, "kernel_launch: occupancy query says %d\n", per_cu); per_cu = 1; }
        (void)hipGetLastError();
        grid = cus * per_cu;
        if (grid <= 0) grid = 256;
    }
    if (grid < 0) return;
    Params p{};
    for (int i = 0; i < 20; ++i) p.in[i] = (const float*)d_in[i];
    p.out = (float*)d_out; p.ws = (unsigned char*)d_ws;
#if N_LAUNCH_MODE == 1
    p.ph_lo = 0; p.ph_hi = NPHASE;
    (void)hipMemsetAsync((unsigned char*)d_ws + WS_BAR, 0, 16384, stream);
    void* args[] = {&p};
    hipError_t e = hipLaunchCooperativeKernel((const void*)mega_fwd, dim3(grid), dim3(512), args, LDS_BYTES, stream);
    if (e != hipSuccess) fprintf(stderr, "cooperative launch failed: %s (grid %d)\n", hipGetErrorString(e), grid);
#else
    for (int ph = 0; ph < NPHASE; ++ph) {
        p.ph_lo = ph; p.ph_hi = ph + 1;
        hipLaunchKernelGGL(mega_fwd, dim3(grid), dim3(512), LDS_BYTES, stream, p);
    }
#endif
}
```

```cpp
#include <hip/hip_runtime.h>
#include <hip/hip_cooperative_groups.h>
#include <cstdio>
#include <cstdint>
namespace cg = cooperative_groups;

#ifndef N_LAUNCH_MODE
#define N_LAUNCH_MODE 1
#endif

typedef unsigned short bf16_t;
typedef short bf16x8 __attribute__((ext_vector_type(8)));
typedef float f32x16 __attribute__((ext_vector_type(16)));
typedef float f32x4 __attribute__((ext_vector_type(4)));
typedef float f32x2 __attribute__((ext_vector_type(2)));
typedef unsigned u32x4 __attribute__((ext_vector_type(4)));
typedef unsigned u32x2 __attribute__((ext_vector_type(2)));
typedef __bf16 bf16x2_t __attribute__((ext_vector_type(2)));

#define DI __device__ __forceinline__
#define GAS __attribute__((address_space(1)))
#define LAS __attribute__((address_space(3)))
#define MFMA(a, b, c) __builtin_amdgcn_mfma_f32_32x32x16_bf16((a), (b), (c), 0, 0, 0)

constexpr int D = 1024, SEQ = 8192, CTX = 256;
constexpr int MLAT = 2 * SEQ;
constexpr int MCTX = 2 * CTX;
constexpr int MTOT = MLAT + MCTX;
constexpr int KVKEYS = SEQ + CTX;
constexpr float EPS = 1e-6f;
constexpr float LOG2E = 1.4426950408889634f;
constexpr float QSCALE_A = 0.125f * 1.4426950408889634f;
constexpr float QSCALE_B = (float)(0.10206207261596575 * 1.4426950408889634);

constexpr size_t WS_MODS = 0;
constexpr size_t WS_ROPEA = WS_MODS + 2 * 3 * 3072 * 4;
constexpr size_t WS_ROPEB = WS_ROPEA + 128 * 16 * 8;
constexpr size_t WS_WT_IN0 = WS_ROPEB + 128 * 8 * 8;
constexpr size_t WS_WT_O0 = WS_WT_IN0 + (size_t)2560 * 1024 * 2;
constexpr size_t WS_WT_IN1 = WS_WT_O0 + (size_t)1024 * 1024 * 2;
constexpr size_t WS_WT_UQ = WS_WT_IN1 + (size_t)1536 * 1024 * 2;
constexpr size_t WS_WT_UKV = WS_WT_UQ + (size_t)1536 * 256 * 2;
constexpr size_t WS_WT_O1 = WS_WT_UKV + (size_t)2048 * 128 * 2;
constexpr size_t WS_CTX1 = WS_WT_O1 + (size_t)1024 * 1024 * 2;
constexpr size_t WS_H = WS_CTX1 + (size_t)MCTX * D * 4;
constexpr size_t WS_SG = WS_H + (size_t)MTOT * D * 2;
constexpr size_t WS_CQN = WS_SG + (size_t)MTOT * D * 2;
constexpr size_t WS_CKVN = WS_CQN + (size_t)MTOT * 256 * 2;
constexpr size_t WS_BIG = WS_CKVN + (size_t)MTOT * 128 * 2;
constexpr size_t WS_Q0 = WS_BIG;
constexpr size_t WS_K0 = WS_Q0 + (size_t)MTOT * D * 2;
constexpr size_t WS_VT0 = WS_K0 + (size_t)MTOT * 256 * 2;
constexpr size_t WS_OG0 = WS_VT0 + (size_t)2 * 256 * KVKEYS * 2;
constexpr size_t WS_Q1 = WS_BIG;
constexpr size_t WS_C416 = WS_BIG;
constexpr int KROW = 240;
constexpr int KV_VOFF = 64 * KROW;
constexpr int KV_TILE_BYTES = KV_VOFF + 64 * 144;
constexpr int KV_NT = KVKEYS / 64;
constexpr size_t WS_KV = WS_Q1 + (size_t)MLAT * 1536 * 2;
constexpr size_t WS_BAR = WS_KV + (size_t)32 * KV_NT * KV_TILE_BYTES;
constexpr size_t WS_SSQ = WS_BAR + 16384;
constexpr size_t WS_END = WS_SSQ + (size_t)2 * MTOT * 4;
static_assert(WS_END <= (size_t)256 * 1024 * 1024, "workspace map exceeds 256 MiB");

constexpr int LDS_BYTES = 2 * 512 * 144;
constexpr int NPHASE = 12;

struct Params {
    const float* in[20];
    float* out;
    unsigned char* ws;
    int ph_lo, ph_hi;
};

DI unsigned pk2(float a, float b) { f32x2 v = {a, b}; bf16x2_t r = __builtin_convertvector(v, bf16x2_t); return __builtin_bit_cast(unsigned, r); }
DI float bflo(unsigned u) { return __uint_as_float(u << 16); }
DI float bfhi(unsigned u) { return __uint_as_float(u & 0xffff0000u); }
DI float wave_sum(float v) {
#pragma unroll
    for (int o = 1; o < 64; o <<= 1) v += __shfl_xor(v, o);
    return v;
}
DI float silu_f(float v) { return v * __builtin_amdgcn_rcpf(1.f + __builtin_amdgcn_exp2f(-1.4426950408889634f * v)); }
DI float ex2(float v) { return __builtin_amdgcn_exp2f(v); }

DI void p0_transpose_unit(const float* W, int K, int N, int Npad, bf16_t* Wt, int r, float* tile, int tid, const float* kscale = nullptr) {
    const int ntn = Npad / 64, nt = r % ntn, kt = r / ntn, n0 = nt * 64, k0 = kt * 64;
#pragma unroll
    for (int j = 0; j < 8; ++j) {
        const int kk = (tid >> 6) + 8 * j, nn = tid & 63, n = n0 + nn;
        tile[kk * 65 + nn] = (n < N) ? W[(size_t)(k0 + kk) * N + n] * (kscale ? kscale[k0 + kk] : 1.f) : 0.f;
    }
    __syncthreads();
    {
        const int nn = tid >> 3, kk8 = (tid & 7) * 8;
        u32x4 o;
        o.x = pk2(tile[(kk8 + 0) * 65 + nn], tile[(kk8 + 1) * 65 + nn]);
        o.y = pk2(tile[(kk8 + 2) * 65 + nn], tile[(kk8 + 3) * 65 + nn]);
        o.z = pk2(tile[(kk8 + 4) * 65 + nn], tile[(kk8 + 5) * 65 + nn]);
        o.w = pk2(tile[(kk8 + 6) * 65 + nn], tile[(kk8 + 7) * 65 + nn]);
        *(u32x4*)(Wt + (size_t)(n0 + nn) * K + k0 + kk8) = o;
    }
    __syncthreads();
}

DI void p0_ada_unit(const Params& p, unsigned char* ws, int u, float* lds, int tid) {
    const int l = u / 96, n0 = (u % 96) * 32;
    const float* W = p.in[l ? 11 : 5];
    const float* bias = p.in[l ? 12 : 6];
    float* sv = lds;
    float* red = lds + 3 * 1024;
    for (int e = tid; e < 3 * 1024; e += 512) {
        const int v = e >> 10, k = e & 1023;
        const float cv = (v < 2) ? p.in[1][v * 1024 + k] : p.in[3][k];
        sv[e] = silu_f(cv);
    }
    __syncthreads();
    const int col = tid & 31, kg = tid >> 5;
    float a0 = 0.f, a1 = 0.f, a2 = 0.f;
#pragma unroll 8
    for (int kk = 0; kk < 64; ++kk) {
        const int k = kg * 64 + kk;
        const float wv = W[(size_t)k * 3072 + n0 + col];
        a0 += sv[k] * wv; a1 += sv[1024 + k] * wv; a2 += sv[2048 + k] * wv;
    }
    red[(kg * 3 + 0) * 32 + col] = a0; red[(kg * 3 + 1) * 32 + col] = a1; red[(kg * 3 + 2) * 32 + col] = a2;
    __syncthreads();
    if (tid < 96) {
        const int v = tid >> 5, c2 = tid & 31;
        float s = bias[n0 + c2];
#pragma unroll
        for (int g = 0; g < 16; ++g) s += red[(g * 3 + v) * 32 + c2];
        ((float*)(ws + WS_MODS))[(l * 3 + v) * 3072 + n0 + c2] = s;
    }
    __syncthreads();
}

DI void phase0(const Params& p, unsigned char* ws, unsigned char* ldsb, int tid) {
    float* lds = (float*)ldsb;
    constexpr int U_ADA = 192, U_ROPE = 6;
    constexpr int U_IN0 = (2560 / 64) * (1024 / 64), U_O = (1024 / 64) * (1024 / 64), U_IN1 = (1536 / 64) * (1024 / 64),
                  U_UQ = (1536 / 64) * (256 / 64), U_UKV = (2048 / 64) * (128 / 64);
    constexpr int NU = U_ADA + U_ROPE + U_IN0 + U_O + U_IN1 + U_UQ + U_UKV + U_O;
    { float* ssq = (float*)(ws + WS_SSQ); for (int e = blockIdx.x * 512 + tid; e < 2 * MTOT; e += gridDim.x * 512) ssq[e] = 0.f; }
    for (int u = blockIdx.x; u < NU; u += gridDim.x) {
        int r = u;
        if (r < U_ADA) { p0_ada_unit(p, ws, r, lds, tid); continue; } r -= U_ADA;
        if (r < U_ROPE) {
            const int e = r * 512 + tid;
            if (e < 2048) { const int pos = e >> 4, j = e & 15; const float inv = powf(10000.f, -(float)j / 16.f); const float a = (float)pos * inv;
                ((f32x2*)(ws + WS_ROPEA))[e] = (f32x2){cosf(a), sinf(a)}; }
            else { const int e2 = e - 2048; const int pos = e2 >> 3, j = e2 & 7; const float inv = powf(10000.f, -(float)j / 8.f); const float a = (float)pos * inv;
                ((f32x2*)(ws + WS_ROPEB))[e2] = (f32x2){cosf(a), sinf(a)}; }
            continue;
        } r -= U_ROPE;
        if (r < U_IN0) { p0_transpose_unit(p.in[7], 1024, 2560, 2560, (bf16_t*)(ws + WS_WT_IN0), r, lds, tid); continue; } r -= U_IN0;
        if (r < U_O) { p0_transpose_unit(p.in[9], 1024, 1024, 1024, (bf16_t*)(ws + WS_WT_O0), r, lds, tid); continue; } r -= U_O;
        if (r < U_IN1) { p0_transpose_unit(p.in[13], 1024, 1440, 1536, (bf16_t*)(ws + WS_WT_IN1), r, lds, tid); continue; } r -= U_IN1;
        if (r < U_UQ) { p0_transpose_unit(p.in[15], 256, 1536, 1536, (bf16_t*)(ws + WS_WT_UQ), r, lds, tid, p.in[14]); continue; } r -= U_UQ;
        if (r < U_UKV) { p0_transpose_unit(p.in[17], 128, 2048, 2048, (bf16_t*)(ws + WS_WT_UKV), r, lds, tid, p.in[16]); continue; } r -= U_UKV;
        p0_transpose_unit(p.in[18], 1024, 1024, 1024, (bf16_t*)(ws + WS_WT_O1), r, lds, tid);
    }
}

template <bool LAT_BF16>
DI void modulate_phase(const float* xlat, const float* xctx, const float* g, const float* mods_l, bf16_t* h, int tid) {
    const int lane = tid & 63, gw = blockIdx.x * 8 + (tid >> 6), ngw = gridDim.x * 8;
    for (int row0 = gw; row0 < MTOT; row0 += 2 * ngw) {
        const float* src[2]; const float* md[2]; int row[2]; bool ok[2];
        f32x4 v[2][4];
#pragma unroll
        for (int q = 0; q < 2; ++q) {
            row[q] = row0 + q * ngw; ok[q] = row[q] < MTOT;
            const int rr = ok[q] ? row[q] : row0;
            if (rr < MLAT) { src[q] = xlat + (size_t)rr * D; md[q] = mods_l + (rr >> 13) * 3072; }
            else { src[q] = xctx + (size_t)(rr - MLAT) * D; md[q] = mods_l + 2 * 3072; }
#pragma unroll
            for (int j = 0; j < 4; ++j) {
                if (LAT_BF16 && rr < MLAT) {
                    const u32x2 b2 = *(const GAS u32x2*)((const bf16_t*)xlat + (size_t)rr * D + lane * 4 + 256 * j);
                    v[q][j] = (f32x4){bflo(b2.x), bfhi(b2.x), bflo(b2.y), bfhi(b2.y)};
                } else v[q][j] = *(const GAS f32x4*)(src[q] + lane * 4 + 256 * j);
            }
        }
#pragma unroll
        for (int q = 0; q < 2; ++q) {
            float ss = 0.f;
#pragma unroll
            for (int j = 0; j < 4; ++j) ss += (v[q][j].x * v[q][j].x + v[q][j].y * v[q][j].y) + (v[q][j].z * v[q][j].z + v[q][j].w * v[q][j].w);
            const float rstd = 1.f / sqrtf(wave_sum(ss) * (1.f / D) + EPS);
            if (ok[q]) {
#pragma unroll
                for (int j = 0; j < 4; ++j) {
                    const int k = lane * 4 + 256 * j;
                    const f32x4 gg = *(const GAS f32x4*)(g + k), sh = *(const GAS f32x4*)(md[q] + k), sc = *(const GAS f32x4*)(md[q] + 1024 + k);
                    const f32x4 o = (v[q][j] * rstd * gg) * (sc + 1.f) + sh;
                    u32x2 w; w.x = pk2(o.x, o.y); w.y = pk2(o.z, o.w);
                    *(GAS u32x2*)(h + (size_t)row[q] * D + k) = w;
                }
            }
        }
    }
}

template <class Epi, int TB = 4>
DI void gemm_phase(const bf16_t* A, const bf16_t* Wt, int Mtiles, int Ntiles, int K, const Epi& epi, unsigned char* lds, int tid) {
    constexpr int RM = 64 * TB;
    const int lane = tid & 63, w = tid >> 6, wt = w >> 2, wf = w & 3, r = lane & 31, hh = lane >> 5;
    const int wu = __builtin_amdgcn_readfirstlane(w);
    const int nk = K >> 6;
    const unsigned swz = (r >> 1) & 7;
    unsigned koff[4];
#pragma unroll
    for (int ks = 0; ks < 4; ++ks) koff[ks] = ((unsigned)(ks * 2 + hh) ^ swz) << 4;
    const int drow = 8 * w + (lane >> 3);
    const int dch = (lane & 7) ^ ((drow >> 1) & 7);
    const size_t dsrc = (size_t)drow * K + dch * 8;
#define G_DMA(kt_, st_)                                                                               \
    _Pragma("unroll") for (int j = 0; j < 4; ++j) {                                                    \
        if (j < TB) __builtin_amdgcn_global_load_lds((const GAS unsigned*)(Ag + (size_t)(j * 64) * K + (kt_) * 64), (LAS unsigned*)(lds + (st_) * 65536 + (j * 8 + wu) * 1024), 16, 0, 0); \
        __builtin_amdgcn_global_load_lds((const GAS unsigned*)(Wg + (size_t)(j * 64) * K + (kt_) * 64), (LAS unsigned*)(lds + (st_) * 65536 + 32768 + (j * 8 + wu) * 1024), 16, 0, 0); \
    }
#define G_BARRIER() { asm volatile("s_waitcnt vmcnt(0) lgkmcnt(0)" ::: "memory"); __builtin_amdgcn_s_barrier(); asm volatile("" ::: "memory"); }
    const int nx = (gridDim.x == 256) ? 8 : 1, xcd = blockIdx.x % nx, nslots = gridDim.x / nx;
    const int nloc = ((Mtiles - xcd + nx - 1) / nx) * Ntiles;
    int u = blockIdx.x / nx;
    const GAS bf16_t* Ag = (const GAS bf16_t*)A + dsrc;
    const GAS bf16_t* Wg = (const GAS bf16_t*)Wt + dsrc;
    if (u < nloc) {
        Ag = (const GAS bf16_t*)(A + (size_t)(xcd + nx * (u / Ntiles)) * RM * K) + dsrc; Wg = (const GAS bf16_t*)(Wt + (size_t)(u % Ntiles) * 256 * K) + dsrc;
        G_DMA(0, 0);
    }
    while (u < nloc) {
        const int nt = u % Ntiles, mt = xcd + nx * (u / Ntiles);
        f32x16 acc[2][TB];
#pragma unroll
        for (int a = 0; a < 2; ++a)
#pragma unroll
            for (int b = 0; b < TB; ++b)
#pragma unroll
                for (int i = 0; i < 16; ++i) acc[a][b][i] = 0.f;
        G_BARRIER();
        for (int kt = 0; kt < nk; ++kt) {
            if (kt + 1 < nk) { G_DMA(kt + 1, (kt + 1) & 1); }
            const unsigned char* sa = lds + (kt & 1) * 65536 + (wt * 32 * TB + r) * 128;
            const unsigned char* sw = lds + (kt & 1) * 65536 + 32768 + (wf * 64 + r) * 128;
#pragma unroll
            for (int ks = 0; ks < 4; ++ks) {
                bf16x8 wfr[2], afr[TB];
#pragma unroll
                for (int fb = 0; fb < 2; ++fb) wfr[fb] = *(const bf16x8*)(sw + fb * 4096 + koff[ks]);
#pragma unroll
                for (int tb = 0; tb < TB; ++tb) afr[tb] = *(const bf16x8*)(sa + tb * 4096 + koff[ks]);
#pragma unroll
                for (int fb = 0; fb < 2; ++fb)
#pragma unroll
                    for (int tb = 0; tb < TB; ++tb) acc[fb][tb] = MFMA(wfr[fb], afr[tb], acc[fb][tb]);
            }
            G_BARRIER();
        }
        const int un = u + nslots;
        if (un < nloc) {
            Ag = (const GAS bf16_t*)(A + (size_t)(xcd + nx * (un / Ntiles)) * RM * K) + dsrc; Wg = (const GAS bf16_t*)(Wt + (size_t)(un % Ntiles) * 256 * K) + dsrc;
            G_DMA(0, 0);
        }
#pragma unroll
        for (int fb = 0; fb < 2; ++fb)
#pragma unroll
            for (int tb = 0; tb < TB; ++tb) epi(nt * 256 + wf * 64 + fb * 32, mt * RM + wt * 32 * TB + tb * 32, acc[fb][tb], r, hh);
        u = un;
    }
    asm volatile("s_waitcnt vmcnt(0)" ::: "memory");
#undef G_DMA
#undef G_BARRIER
}

DI void store_bf16x4(bf16_t* dst, float a, float b, float c, float d) { u32x2 w; w.x = pk2(a, b); w.y = pk2(c, d); *(GAS u32x2*)dst = w; }
DI void store_bf16_row32(bf16_t* rowp, const float (&v)[16], int hh) {
#pragma unroll
    for (int p = 0; p < 2; ++p) {
        unsigned ax = pk2(v[8 * p + 0], v[8 * p + 1]), ay = pk2(v[8 * p + 2], v[8 * p + 3]);
        unsigned bx = pk2(v[8 * p + 4], v[8 * p + 5]), by = pk2(v[8 * p + 6], v[8 * p + 7]);
        const auto rx = __builtin_amdgcn_permlane32_swap(ax, bx, false, false);
        const auto ry = __builtin_amdgcn_permlane32_swap(ay, by, false, false);
        u32x4 w; w.x = rx[0]; w.y = ry[0]; w.z = rx[1]; w.w = ry[1];
        *(GAS u32x4*)(rowp + 16 * p + 8 * hh) = w;
    }
}
DI void store_bf16_tr32(bf16_t* out, size_t ld, const f32x16& acc, unsigned char* patch, int r, int hh) {
#pragma unroll
    for (int i = 0; i < 16; ++i) { const int f = (i & 3) + 8 * (i >> 2) + 4 * hh; *(bf16_t*)(patch + f * 80 + r * 2) = (bf16_t)(pk2(acc[i], 0.f) & 0xffffu); }
    const int lane = r + 32 * hh;
#pragma unroll
    for (int q = 0; q < 2; ++q) {
        const int ch = lane + 64 * q, f = ch >> 2, tc = ch & 3;
        const u32x4 wv = *(const u32x4*)(patch + f * 80 + tc * 16);
        *(GAS u32x4*)(out + (size_t)f * ld + tc * 8) = wv;
    }
}
DI void store_bf16(bf16_t* dst, float a) { *(GAS bf16_t*)dst = (bf16_t)(pk2(a, 0.f) & 0xffffu); }

struct EpiNull {
    float* sink;
    DI void operator()(int fbase, int tbase, const f32x16& acc, int r, int hh) const {
        float s = 0.f;
#pragma unroll
        for (int i = 0; i < 16; ++i) s += acc[i];
        if (s == 123.456f) sink[0] = s;
    }
};
struct EpiAin {
    bf16_t* q0; bf16_t* k0; bf16_t* vt0; bf16_t* sg; const f32x2* ropeA; unsigned char* patch;
    DI void operator()(int fbase, int tbase, const f32x16& acc, int r, int hh) const {
        const int t = tbase + r;
        const bool latent = t < MLAT;
        if (fbase < 1280) {
            f32x16 v = acc;
            if (latent) {
                const int pos = t & (SEQ - 1);
                const int pp = (fbase & 32) ? (pos & 63) : (pos >> 6);
                const f32x2* tab = ropeA + pp * 16;
#pragma unroll
                for (int i = 0; i < 8; ++i) {
                    const int j = (i & 3) + 8 * (i >> 2) + 4 * hh;
                    const f32x2 cs = tab[j];
                    const float a = acc[i], b = acc[i + 8];
                    v[i] = a * cs.x - b * cs.y; v[i + 8] = b * cs.x + a * cs.y;
                }
            }
            float o[16];
            if (fbase < 1024) {
#pragma unroll
                for (int i = 0; i < 16; ++i) o[i] = v[i] * QSCALE_A;
                store_bf16_row32(q0 + (size_t)t * 1024 + fbase, o, hh);
            } else {
#pragma unroll
                for (int i = 0; i < 16; ++i) o[i] = v[i];
                store_bf16_row32(k0 + (size_t)t * 256 + (fbase - 1024), o, hh);
            }
        } else if (fbase < 1536) {
            const int f0 = fbase - 1280;
            int b, key;
            if (latent) { b = t >> 13; key = t & (SEQ - 1); } else { const int tc = t - MLAT; b = tc >> 8; key = SEQ + (tc & 255); }
            store_bf16_tr32(vt0 + (size_t)(b * 256 + f0) * KVKEYS + (key - r), KVKEYS, acc, patch, r, hh);
        } else {
            float o[16];
#pragma unroll
            for (int i = 0; i < 16; ++i) o[i] = silu_f(acc[i]);
            store_bf16_row32(sg + (size_t)t * 1024 + (fbase - 1536), o, hh);
        }
    }
};

struct EpiWo0 {
    const float* xres; bf16_t* xb; const float* cres; float* cdst; const float* mods_l;
    DI void operator()(int fbase, int tbase, const f32x16& acc, int r, int hh) const {
        const int t = tbase + r;
        if (t < MLAT) {
            const float* res = xres + (size_t)t * D; const float* gate = mods_l + (t >> 13) * 3072 + 2048;
            float o[16];
#pragma unroll
            for (int g = 0; g < 4; ++g) {
                const int f = fbase + 8 * g + 4 * hh;
                const f32x4 rr = *(const GAS f32x4*)(res + f), gg = *(const GAS f32x4*)(gate + f);
                o[4 * g] = rr.x + gg.x * acc[4 * g]; o[4 * g + 1] = rr.y + gg.y * acc[4 * g + 1]; o[4 * g + 2] = rr.z + gg.z * acc[4 * g + 2]; o[4 * g + 3] = rr.w + gg.w * acc[4 * g + 3];
            }
            store_bf16_row32(xb + (size_t)t * D + fbase, o, hh);
        } else {
            const float* res = cres + (size_t)(t - MLAT) * D; float* dst = cdst + (size_t)(t - MLAT) * D; const float* gate = mods_l + 2 * 3072 + 2048;
#pragma unroll
            for (int g = 0; g < 4; ++g) {
                const int f = fbase + 8 * g + 4 * hh;
                const f32x4 rr = *(const GAS f32x4*)(res + f), gg = *(const GAS f32x4*)(gate + f);
                f32x4 o; o.x = rr.x + gg.x * acc[4 * g]; o.y = rr.y + gg.y * acc[4 * g + 1]; o.z = rr.z + gg.z * acc[4 * g + 2]; o.w = rr.w + gg.w * acc[4 * g + 3];
                *(GAS f32x4*)(dst + f) = o;
            }
        }
    }
};
struct EpiWo1 {
    const bf16_t* xb; bf16_t* x2b; const float* mods_l;
    DI void operator()(int fbase, int tbase, const f32x16& acc, int r, int hh) const {
        const int t = tbase + r;
        const bf16_t* res = xb + (size_t)t * D; const float* gate = mods_l + (t >> 13) * 3072 + 2048;
        float o[16];
#pragma unroll
        for (int g = 0; g < 4; ++g) {
            const int f = fbase + 8 * g + 4 * hh;
            const u32x2 rb = *(const GAS u32x2*)(res + f); const f32x4 gg = *(const GAS f32x4*)(gate + f);
            o[4 * g] = bflo(rb.x) + gg.x * acc[4 * g]; o[4 * g + 1] = bfhi(rb.x) + gg.y * acc[4 * g + 1]; o[4 * g + 2] = bflo(rb.y) + gg.z * acc[4 * g + 2]; o[4 * g + 3] = bfhi(rb.y) + gg.w * acc[4 * g + 3];
        }
        store_bf16_row32(x2b + (size_t)t * D + fbase, o, hh);
    }
};

struct EpiBin {
    bf16_t* cq; bf16_t* ckv; float* ssq; unsigned char* kv; const f32x2* ropeB; bf16_t* sg;
    DI void operator()(int fbase, int tbase, const f32x16& acc, int r, int hh) const {
        const int t = tbase + r;
        if (fbase < 384) {
            float o[16]; float s = 0.f;
#pragma unroll
            for (int i = 0; i < 16; ++i) { o[i] = acc[i]; s += acc[i] * acc[i]; }
            s += __shfl_xor(s, 32);
            if (fbase < 256) { store_bf16_row32(cq + (size_t)t * 256 + fbase, o, hh); if (hh == 0) atomicAdd(ssq + t, s); }
            else { store_bf16_row32(ckv + (size_t)t * 128 + (fbase - 256), o, hh); if (hh == 0) atomicAdd(ssq + MTOT + t, s); }
        } else if (fbase < 416) {
            float o[16];
            int b, key;
            if (t < MLAT) {
                b = t >> 13; key = t & (SEQ - 1);
                const f32x2* tr = ropeB + (key >> 6) * 8 + 4 * hh;
                const f32x2* tc = ropeB + (key & 63) * 8 + 4 * hh;
#pragma unroll
                for (int i = 0; i < 4; ++i) {
                    const f32x2 c1 = tr[i]; const float a = acc[i], b2 = acc[i + 4];
                    o[i] = a * c1.x - b2 * c1.y; o[i + 4] = b2 * c1.x + a * c1.y;
                    const f32x2 c2 = tc[i]; const float a2 = acc[i + 8], b3 = acc[i + 12];
                    o[i + 8] = a2 * c2.x - b3 * c2.y; o[i + 12] = b3 * c2.x + a2 * c2.y;
                }
            } else {
                const int tc2 = t - MLAT; b = tc2 >> 8; key = SEQ + (tc2 & 255);
#pragma unroll
                for (int i = 0; i < 16; ++i) o[i] = acc[i];
            }
            unsigned char* base = kv + ((size_t)(b * 16) * KV_NT + (key >> 6)) * KV_TILE_BYTES + (key & 63) * KROW + 128;
#pragma unroll
            for (int p = 0; p < 2; ++p) {
                unsigned ax = pk2(o[8 * p + 0], o[8 * p + 1]), ay = pk2(o[8 * p + 2], o[8 * p + 3]);
                unsigned bx = pk2(o[8 * p + 4], o[8 * p + 5]), by = pk2(o[8 * p + 6], o[8 * p + 7]);
                const auto rx = __builtin_amdgcn_permlane32_swap(ax, bx, false, false);
                const auto ry = __builtin_amdgcn_permlane32_swap(ay, by, false, false);
                u32x4 wv; wv.x = rx[0]; wv.y = ry[0]; wv.z = rx[1]; wv.w = ry[1];
#pragma unroll
                for (int hd = 0; hd < 16; ++hd) *(GAS u32x4*)(base + (size_t)hd * KV_NT * KV_TILE_BYTES + (16 * p + 8 * hh) * 2) = wv;
            }
        } else if (fbase < 1440) {
            float o[16];
#pragma unroll
            for (int i = 0; i < 16; ++i) o[i] = silu_f(acc[i]);
            store_bf16_row32(sg + (size_t)t * 1024 + (fbase - 416), o, hh);
        }
    }
};

struct EpiUq {
    bf16_t* q1; const f32x2* ropeB; const float* ssq;
    DI void operator()(int fbase, int tbase, const f32x16& acc, int r, int hh) const {
        const int t = tbase + r;
        f32x16 v = acc;
        if (((fbase >> 5) % 3) == 2) {
            const int pos = t & (SEQ - 1);
            const f32x2* tr = ropeB + (pos >> 6) * 8 + 4 * hh;
            const f32x2* tc = ropeB + (pos & 63) * 8 + 4 * hh;
#pragma unroll
            for (int i = 0; i < 4; ++i) {
                const f32x2 c1 = tr[i]; const float a = acc[i], b = acc[i + 4];
                v[i] = a * c1.x - b * c1.y; v[i + 4] = b * c1.x + a * c1.y;
                const f32x2 c2 = tc[i]; const float a2 = acc[i + 8], b2 = acc[i + 12];
                v[i + 8] = a2 * c2.x - b2 * c2.y; v[i + 12] = b2 * c2.x + a2 * c2.y;
            }
        }
        const float rs = QSCALE_B / sqrtf(ssq[t] * (1.f / 256.f) + EPS);
        float o[16];
#pragma unroll
        for (int i = 0; i < 16; ++i) o[i] = v[i] * rs;
        store_bf16_row32(q1 + (size_t)t * 1536 + fbase, o, hh);
    }
};

struct EpiUkv {
    unsigned char* kv; unsigned char* patch; const float* ssq;
    DI void operator()(int fbase, int tbase, const f32x16& acc, int r, int hh) const {
        const int t = tbase + r;
        const int head = fbase >> 7, dd0 = fbase & 127;
        int b, key;
        if (t < MLAT) { b = t >> 13; key = t & (SEQ - 1); } else { const int tc = t - MLAT; b = tc >> 8; key = SEQ + (tc & 255); }
        unsigned char* base = kv + ((size_t)(b * 16 + head) * KV_NT + (key >> 6)) * KV_TILE_BYTES;
        const int kin = key & 63;
        const float rs = 1.f / sqrtf(ssq[MTOT + t] * (1.f / 128.f) + EPS);
        if (dd0 < 64) {
            float o[16];
#pragma unroll
            for (int i = 0; i < 16; ++i) o[i] = acc[i] * rs;
            store_bf16_row32((bf16_t*)(base + kin * KROW) + dd0, o, hh);
        } else {
            f32x16 sv = acc * rs;
            store_bf16_tr32((bf16_t*)(base + KV_VOFF + (dd0 - 64) * 144) + (kin - r), 72, sv, patch, r, hh);
        }
    }
};

DI void prep_b_phase(const Params& p, unsigned char* ws, int tid) {
    const int lane = tid & 63, gw = blockIdx.x * 8 + (tid >> 6), ngw = gridDim.x * 8;
    const float* c416 = (const float*)(ws + WS_C416);
    bf16_t* cqn = (bf16_t*)(ws + WS_CQN);
    bf16_t* ckvn = (bf16_t*)(ws + WS_CKVN);
    const f32x2* ropeB = (const f32x2*)(ws + WS_ROPEB);
    const float* qg = p.in[14]; const float* kvg = p.in[16];
    for (int t = gw; t < MTOT; t += ngw) {
        const float* c = c416 + (size_t)t * 416;
        const f32x4 a = *(const f32x4*)(c + lane * 4);
        const float s1 = wave_sum((a.x * a.x + a.y * a.y) + (a.z * a.z + a.w * a.w));
        const float r1 = 1.f / sqrtf(s1 * (1.f / 256.f) + EPS);
        const f32x4 g1 = *(const f32x4*)(qg + lane * 4);
        store_bf16x4(cqn + (size_t)t * 256 + lane * 4, a.x * r1 * g1.x, a.y * r1 * g1.y, a.z * r1 * g1.z, a.w * r1 * g1.w);
        const f32x2 bq = *(const f32x2*)(c + 256 + lane * 2);
        const float s2 = wave_sum(bq.x * bq.x + bq.y * bq.y);
        const float r2 = 1.f / sqrtf(s2 * (1.f / 128.f) + EPS);
        const f32x2 g2 = *(const f32x2*)(kvg + lane * 2);
        *(unsigned*)(ckvn + (size_t)t * 128 + lane * 2) = pk2(bq.x * r2 * g2.x, bq.y * r2 * g2.y);
        {
            const int hd = lane >> 2, cc = lane & 3;
            const f32x4 xa = *(const GAS f32x4*)(c + 384 + 8 * cc), xb = *(const GAS f32x4*)(c + 384 + 8 * cc + 4);
            const f32x4 ya = *(const GAS f32x4*)(c + 384 + 8 * (cc ^ 1)), yb = *(const GAS f32x4*)(c + 384 + 8 * (cc ^ 1) + 4);
            float xo[8] = {xa.x, xa.y, xa.z, xa.w, xb.x, xb.y, xb.z, xb.w};
            const float yo[8] = {ya.x, ya.y, ya.z, ya.w, yb.x, yb.y, yb.z, yb.w};
            int b, key;
            if (t < MLAT) {
                b = t >> 13; key = t & (SEQ - 1);
                const int pp = (cc < 2) ? (key >> 6) : (key & 63);
                const float sgn = (cc & 1) ? 1.f : -1.f;
#pragma unroll
                for (int j = 0; j < 8; ++j) { const f32x2 cs = ropeB[pp * 8 + j]; xo[j] = xo[j] * cs.x + sgn * yo[j] * cs.y; }
            } else { const int tc = t - MLAT; b = tc >> 8; key = SEQ + (tc & 255); }
            u32x4 wv; wv.x = pk2(xo[0], xo[1]); wv.y = pk2(xo[2], xo[3]); wv.z = pk2(xo[4], xo[5]); wv.w = pk2(xo[6], xo[7]);
            unsigned char* dst = ws + WS_KV + ((size_t)(b * 16 + hd) * KV_NT + (key >> 6)) * KV_TILE_BYTES + (key & 63) * KROW + (64 + 8 * cc) * 2;
            *(GAS u32x4*)dst = wv;
        }
    }
}

DI float max3f_(float a, float b, float c) { return fmaxf(fmaxf(a, b), c); }
DI void softmax_pv(f32x16 (&S)[2], f32x16 (&O)[2], float& m, float& l, const unsigned char* vl, int r, int hh) {
    float e[2][16];
    float lt = 0.f;
#pragma unroll
    for (int sb = 0; sb < 2; ++sb)
#pragma unroll
        for (int i = 0; i < 16; ++i) { e[sb][i] = ex2(S[sb][i] - m); lt += e[sb][i]; }
    if (__any(!(lt <= 1.0995116e12f))) {
        float mx = max3f_(S[0][0], S[0][1], S[0][2]);
#pragma unroll
        for (int i = 3; i < 15; i += 2) mx = max3f_(mx, S[0][i], S[0][i + 1]);
        mx = max3f_(mx, S[0][15], S[1][0]);
#pragma unroll
        for (int i = 1; i < 15; i += 2) mx = max3f_(mx, S[1][i], S[1][i + 1]);
        mx = fmaxf(mx, S[1][15]);
        mx = fmaxf(mx, __shfl_xor(mx, 32));
        const float mn = fmaxf(m, mx), alpha = ex2(m - mn);
        m = mn; l *= alpha; lt = 0.f;
#pragma unroll
        for (int i = 0; i < 16; ++i) { O[0][i] *= alpha; O[1][i] *= alpha; }
#pragma unroll
        for (int sb = 0; sb < 2; ++sb)
#pragma unroll
            for (int i = 0; i < 16; ++i) { e[sb][i] = ex2(S[sb][i] - mn); lt += e[sb][i]; }
    }
    l += lt;
#pragma unroll
    for (int sb = 0; sb < 2; ++sb)
#pragma unroll
        for (int s = 0; s < 2; ++s) {
            u32x4 pw;
            pw.x = pk2(e[sb][8 * s + 0], e[sb][8 * s + 1]); pw.y = pk2(e[sb][8 * s + 2], e[sb][8 * s + 3]);
            pw.z = pk2(e[sb][8 * s + 4], e[sb][8 * s + 5]); pw.w = pk2(e[sb][8 * s + 6], e[sb][8 * s + 7]);
            const bf16x8 pf = __builtin_bit_cast(bf16x8, pw);
#pragma unroll
            for (int db = 0; db < 2; ++db) {
                const bf16x8 vf = *(const bf16x8*)(vl + (db * 32 + r) * 144 + (sb * 32 + s * 16 + hh * 8) * 2);
                O[db] = MFMA(vf, pf, O[db]);
            }
        }
}

DI void attn_store(const f32x16 (&O)[2], float l, const bf16_t* sg, bf16_t* og, size_t rowoff, int hh) {
    const float lt = l + __shfl_xor(l, 32);
    const float inv = 1.f / lt;
#pragma unroll
    for (int db = 0; db < 2; ++db) {
        float o[16];
#pragma unroll
        for (int g = 0; g < 4; ++g) {
            const size_t idx = rowoff + db * 32 + 8 * g + 4 * hh;
            const u32x2 sv = *(const GAS u32x2*)(sg + idx);
            o[4 * g] = O[db][4 * g] * inv * bflo(sv.x); o[4 * g + 1] = O[db][4 * g + 1] * inv * bfhi(sv.x);
            o[4 * g + 2] = O[db][4 * g + 2] * inv * bflo(sv.y); o[4 * g + 3] = O[db][4 * g + 3] * inv * bfhi(sv.y);
        }
        store_bf16_row32(og + rowoff + db * 32, o, hh);
    }
}

DI void attn_a_phase(const Params& p, unsigned char* ws, unsigned char* lds, int tid) {
    const int lane = tid & 63, w = tid >> 6, r = lane & 31, hh = lane >> 5;
    const int pr = (r & ~12) | ((r & 4) << 1) | ((r & 8) >> 1);
    const int qs = w & 3, hp = w >> 2;
    const bf16_t* q0 = (const bf16_t*)(ws + WS_Q0);
    const bf16_t* k0 = (const bf16_t*)(ws + WS_K0);
    const bf16_t* vt0 = (const bf16_t*)(ws + WS_VT0);
    const bf16_t* sg = (const bf16_t*)(ws + WS_SG);
    bf16_t* og = (bf16_t*)(ws + WS_OG0);
    const float* sinks = p.in[8];
    const int lrow = tid >> 3, lch = tid & 7;
    for (int round = 0;; ++round) {
        int u;
        if (gridDim.x == 256) {
            const int j = blockIdx.x;
            if (round == 0) u = j; else if (round == 1) u = (j < 16) ? 496 + j : 240 + j; else if (round == 2 && j < 16) u = 512 + j; else break;
        } else { u = blockIdx.x + round * gridDim.x; if (u >= 528) break; }
        int b, kvh, iblk, tq0, ntiles, ploc0;
        bool latent;
        if (u < 512) {
            latent = true;
            if (u < 496) { b = u / 248; const int rem = u % 248; iblk = 1 + (rem >> 2); kvh = rem & 3; }
            else { const int li = u - 496; b = li >> 3; iblk = ((li >> 2) & 1) ? 63 : 0; kvh = li & 3; }
            tq0 = b * SEQ + iblk * 128 + qs * 32;
            ploc0 = (iblk > 0) ? (iblk - 1) * 128 : 0; const int pend = (iblk < 63) ? (iblk + 2) * 128 : SEQ; ntiles = 4 + ((pend - ploc0) >> 6); }
        else { const int uc = u - 512; latent = false; b = uc >> 3; iblk = 0; kvh = uc & 3; tq0 = MLAT + b * CTX + ((uc >> 2) & 1) * 128 + qs * 32; ploc0 = 0; ntiles = 4; }
        const int hd0 = kvh * 4 + hp * 2;
        bf16x8 qf[2][4];
#pragma unroll
        for (int e = 0; e < 2; ++e)
#pragma unroll
            for (int ks = 0; ks < 4; ++ks) qf[e][ks] = *(const bf16x8*)(q0 + (size_t)(tq0 + r) * 1024 + (hd0 + e) * 64 + ks * 16 + hh * 8);
        f32x16 O[2][2];
        float m[2], l[2];
#pragma unroll
        for (int e = 0; e < 2; ++e) {
            m[e] = sinks[hd0 + e] * LOG2E; l[e] = hh ? 0.f : 1.f;
#pragma unroll
            for (int i = 0; i < 16; ++i) { O[e][0][i] = 0.f; O[e][1][i] = 0.f; }
        }
        const int qlo = iblk * 128 + qs * 32;
        u32x4 rk, rv;
#define A_LOAD(ti_)                                                                                             \
    {                                                                                                           \
        int ktok0_, vkey0_;                                                                                     \
        if ((ti_) < 4) { ktok0_ = MLAT + b * CTX + (ti_) * 64; vkey0_ = SEQ + (ti_) * 64; }                     \
        else { const int p0_ = ploc0 + ((ti_) - 4) * 64; ktok0_ = b * SEQ + p0_; vkey0_ = p0_; }                \
        rk = *(const GAS u32x4*)(const void*)(k0 + (size_t)(ktok0_ + lrow) * 256 + kvh * 64 + lch * 8);        \
        rv = *(const GAS u32x4*)(const void*)(vt0 + (size_t)(b * 256 + kvh * 64 + lrow) * KVKEYS + vkey0_ + lch * 8); \
    }
#define A_STORE(st_)                                                                                            \
    {                                                                                                           \
        unsigned char* sb_ = lds + (st_) * 18432 + lrow * 144 + lch * 16;                                       \
        *(u32x4*)sb_ = rk; *(u32x4*)(sb_ + 9216) = rv;                                                          \
    }
        A_LOAD(0);
        A_STORE(0);
        __syncthreads();
        for (int ti = 0; ti < ntiles; ++ti) {
            if (ti + 1 < ntiles) { A_LOAD(ti + 1); }
            const unsigned char* kl = lds + (ti & 1) * 18432;
            const unsigned char* vl = kl + 9216;
            const bool masked = ti >= 4;
            const int kpos0 = ploc0 + (ti - 4) * 64;
            const bool skip = masked && (kpos0 > qlo + 31 + 128 || kpos0 + 63 < qlo - 128);
            if (!skip) {
                f32x16 S[2][2];
#pragma unroll
                for (int e = 0; e < 2; ++e)
#pragma unroll
                    for (int sb = 0; sb < 2; ++sb)
#pragma unroll
                        for (int i = 0; i < 16; ++i) S[e][sb][i] = 0.f;
#pragma unroll
                for (int sb = 0; sb < 2; ++sb)
#pragma unroll
                    for (int ks = 0; ks < 4; ++ks) {
                        const bf16x8 kf = *(const bf16x8*)(kl + (sb * 32 + pr) * 144 + ks * 32 + hh * 16);
                        S[0][sb] = MFMA(kf, qf[0][ks], S[0][sb]);
                        S[1][sb] = MFMA(kf, qf[1][ks], S[1][sb]);
                    }
                if (masked && !(kpos0 >= qlo - 97 && kpos0 <= qlo + 65)) {
                    const int qp = qlo + r;
#pragma unroll
                    for (int sb = 0; sb < 2; ++sb)
#pragma unroll
                        for (int i = 0; i < 16; ++i) {
                            const int kp = kpos0 + sb * 32 + 16 * (i >> 3) + 8 * hh + (i & 7);
                            const int dlt = qp - kp;
                            if (dlt > 128 || dlt < -128) { S[0][sb][i] = -1e30f; S[1][sb][i] = -1e30f; }
                        }
                }
                softmax_pv(S[0], O[0], m[0], l[0], vl, r, hh);
                softmax_pv(S[1], O[1], m[1], l[1], vl, r, hh);
            }
            if (ti + 1 < ntiles) { A_STORE((ti + 1) & 1); }
            __syncthreads();
        }
#undef A_LOAD
#undef A_STORE
        (void)latent;
#pragma unroll
        for (int e = 0; e < 2; ++e) attn_store(O[e], l[e], sg, og, (size_t)(tq0 + r) * 1024 + (hd0 + e) * 64, hh);
    }
}

DI float max3f(float a, float b, float c) { return fmaxf(fmaxf(a, b), c); }
constexpr float DEFER_THR = 8.f;
constexpr int BK_OFF0 = 0, BV_OFF0 = 2 * KV_VOFF, BV_SZ = 64 * 144;
template <int MODE>
DI void attn_b_phase(unsigned char* ws, unsigned char* lds, int tid) {
    const int lane = tid & 63, w = tid >> 6, r = lane & 31, hh = lane >> 5;
    const int pr = (r & ~12) | ((r & 4) << 1) | ((r & 8) >> 1);
    const bf16_t* q1 = (const bf16_t*)(ws + WS_Q1);
    const bf16_t* sg = (const bf16_t*)(ws + WS_SG);
    bf16_t* og = (bf16_t*)(ws + WS_H);
    const int wu = __builtin_amdgcn_readfirstlane(w);
    const u32x4 konev = {hh ? 0u : 0x3F80u, 0u, 0u, 0u};
    const bf16x8 kone = __builtin_bit_cast(bf16x8, konev);
    const unsigned koff = pr * KROW + hh * 16;
    const unsigned voff = r * 144 + hh * 16;
    if (wu >= 4) __builtin_amdgcn_s_setprio(1);
    bool staged = false;
    for (int it = 0;; ++it) {
        const int u = blockIdx.x + it * gridDim.x;
        if (u >= 1024) break;
        int bh, qt;
        if (gridDim.x == 256) { bh = it * 8 + (blockIdx.x & 7); qt = blockIdx.x >> 3; } else { bh = u >> 5; qt = u & 31; }
        const int b = bh >> 4, h = bh & 15;
        const int t0 = b * SEQ + qt * 256 + w * 32;
        bf16x8 qf[6];
#pragma unroll
        for (int ks = 0; ks < 6; ++ks) qf[ks] = *(const bf16x8*)(q1 + (size_t)(t0 + r) * 1536 + h * 96 + ks * 16 + hh * 8);
        f32x16 O[2];
#pragma unroll
        for (int i = 0; i < 16; ++i) { O[0][i] = 0.f; O[1][i] = 0.f; }
        float m = 0.f, l = 0.f;
        unsigned q6 = 0u;
        bool refnz = false;
        const GAS unsigned char* kvb = (const GAS unsigned char*)(ws + WS_KV + (size_t)bh * KV_NT * KV_TILE_BYTES);
        const bool has_next = u + (int)gridDim.x < 1024;
        const int bh_next = has_next ? ((gridDim.x == 256) ? (it + 1) * 8 + (blockIdx.x & 7) : (u + (int)gridDim.x) >> 5) : bh;
        const GAS unsigned char* kvn = (const GAS unsigned char*)(ws + WS_KV + (size_t)bh_next * KV_NT * KV_TILE_BYTES);
#define B_DMAP(kp_, vp_, ko_, vo_)     \
    {                                                                                                 \
        const GAS unsigned char* sk_ = (kp_) + lane * 16;                                             \
        const GAS unsigned char* sv_ = (vp_) + lane * 16;                                             \
        const GAS unsigned char* s1_ = (wu < 7) ? sk_ + (8 + wu) * 1024 : sv_ + 15 * 1024;            \
        const unsigned d1_ = (wu < 7) ? (ko_) + (8 + wu) * 1024 : (vo_);                              \
        __builtin_amdgcn_global_load_lds((const GAS unsigned*)(sk_ + wu * 1024), (LAS unsigned*)(lds + (ko_) + wu * 1024), 16, 0, 0); \
        __builtin_amdgcn_global_load_lds((const GAS unsigned*)s1_, (LAS unsigned*)(lds + d1_), 16, 0, 0); \
        __builtin_amdgcn_global_load_lds((const GAS unsigned*)(sv_ + (16 + wu) * 1024), (LAS unsigned*)(lds + (vo_) + (1 + wu) * 1024), 16, 0, 0); \
    }
#define B_DMA(kt_, vt_, ko_, vo_) B_DMAP(kvb + (size_t)(kt_) * KV_TILE_BYTES, kvb + (size_t)(vt_) * KV_TILE_BYTES, ko_, vo_)
#define B_BARRIER() { if (MODE != 4) { asm volatile("s_waitcnt vmcnt(0) lgkmcnt(0)" ::: "memory"); __builtin_amdgcn_s_barrier(); asm volatile("" ::: "memory"); } }
#define B_QK(S_, ko_)                                                                                 \
    {                                                                                                 \
        const unsigned char* kl_ = lds + (ko_) + koff;                                                \
        u32x4 q6v_ = {q6, 0u, 0u, 0u};                                                                \
        const bf16x8 q6f_ = __builtin_bit_cast(bf16x8, q6v_);                                         \
        _Pragma("unroll") for (int sb = 0; sb < 2; ++sb) {                                            \
            _Pragma("unroll") for (int i = 0; i < 16; ++i) S_[sb][i] = 0.f;                           \
            _Pragma("unroll") for (int ks = 0; ks < 6; ++ks) {                                        \
                const bf16x8 kf_ = *(const bf16x8*)(kl_ + sb * 32 * KROW + ks * 32);                  \
                S_[sb] = MFMA(kf_, qf[ks], S_[sb]);                                                   \
            }                                                                                         \
            S_[sb] = MFMA(kone, q6f_, S_[sb]);                                                        \
        }                                                                                             \
    }
#define B_PV(vo_)                                                                                     \
    {                                                                                                 \
        const unsigned char* vl_ = lds + (vo_) + voff;                                                \
        _Pragma("unroll") for (int sb = 0; sb < 2; ++sb)                                              \
            _Pragma("unroll") for (int s = 0; s < 2; ++s) {                                           \
                const bf16x8 pf_ = __builtin_bit_cast(bf16x8, pw[sb][s]);                             \
                _Pragma("unroll") for (int db = 0; db < 2; ++db) {                                    \
                    const bf16x8 vf_ = (MODE == 5) ? qf[sb * 2 + s] : *(const bf16x8*)(vl_ + db * 32 * 144 + (sb * 32 + s * 16) * 2); \
                    O[db] = MFMA(vf_, pf_, O[db]);                                                    \
                }                                                                                     \
            }                                                                                         \
    }
        if (!staged) {
            B_DMA(0, 0, BK_OFF0, BV_OFF0);
            B_DMA(1, 1, KV_VOFF, BV_OFF0 + BV_SZ);
            { const u32x4 z = {0u, 0u, 0u, 0u}; *(u32x4*)(lds + BV_OFF0 + 2 * BV_SZ + tid * 16) = z; if (tid < 64) *(u32x4*)(lds + BV_OFF0 + 2 * BV_SZ + 8192 + tid * 16) = z; }
            B_BARRIER();
        }
        f32x16 S0[2], S1[2];
        B_QK(S0, BK_OFF0);
        B_BARRIER();
        u32x4 pw[2][2];
#pragma unroll
        for (int sb = 0; sb < 2; ++sb)
#pragma unroll
            for (int s = 0; s < 2; ++s) pw[sb][s] = (u32x4){0u, 0u, 0u, 0u};
        unsigned kcur = BK_OFF0, knext = KV_VOFF;
        unsigned vprev = BV_OFF0 + 2 * BV_SZ, vcur = BV_OFF0, vnext = BV_OFF0 + BV_SZ;
#define B_UNIT(Sa_, j_)                                                                               \
    if (MODE != 3 && MODE != 4) {                                                                     \
        const float e0_ = ex2(Sa_[(j_) >> 3][2 * ((j_) & 7)]), e1_ = ex2(Sa_[(j_) >> 3][2 * ((j_) & 7) + 1]); \
        lt_ += e0_; lt_ += e1_;                                                                       \
        pw[(j_) >> 3][((j_) >> 2) & 1][(j_) & 3] = pk2(e0_, e1_);                                     \
    }
#define B_KFRAG(g_, NKS_) ((MODE == 5) ? qf[(g_) % 6] : (((g_) % (NKS_)) < 6 ? *(const bf16x8*)(kl_ + ((g_) / (NKS_)) * 32 * KROW + ((g_) % (NKS_)) * 32) : kone))
#define B_CHUNK(Sb_, g_, NKS_, kf_)                                                                   \
    {                                                                                                 \
        if (((g_) % (NKS_)) == 0) { _Pragma("unroll") for (int i = 0; i < 16; ++i) Sb_[(g_) / (NKS_)][i] = 0.f; } \
        Sb_[(g_) / (NKS_)] = MFMA(kf_, (((g_) % (NKS_)) < 6 ? qf[((g_) % (NKS_)) < 6 ? ((g_) % (NKS_)) : 0] : q6f_), Sb_[(g_) / (NKS_)]); \
        if ((g_) + 3 < 2 * (NKS_)) kf_ = B_KFRAG((g_) + 3, NKS_);                                     \
    }
#define B_ITER(Sa_, Sb_, kt_)                                                                         \
    {                                                                                                 \
        if (MODE < 2) {                                                                               \
            const GAS unsigned char* kp_ = ((kt_) + 2 < KV_NT) ? kvb + (size_t)((kt_) + 2) * KV_TILE_BYTES : kvn + (size_t)((kt_) + 2 - KV_NT) * KV_TILE_BYTES; \
            const GAS unsigned char* vp_ = ((kt_) + 1 < KV_NT) ? kvb + (size_t)((kt_) + 1) * KV_TILE_BYTES : kvn;                                           \
            B_DMAP(kp_, vp_, kcur, vnext);                                                            \
        }                                                                                             \
        if (MODE != 1) {                                                                              \
                                                                                      \
        B_PV(vprev);                                                                                  \
          \
        float mx = 0.f;                                                                               \
        if ((kt_) == 0 && MODE != 3 && MODE != 4) {                                                   \
        mx = max3f(Sa_[0][0], Sa_[0][1], Sa_[0][2]);                                                  \
        _Pragma("unroll") for (int i = 3; i < 15; i += 2) mx = max3f(mx, Sa_[0][i], Sa_[0][i + 1]);   \
        mx = max3f(mx, Sa_[0][15], Sa_[1][0]);                                                        \
        _Pragma("unroll") for (int i = 1; i < 15; i += 2) mx = max3f(mx, Sa_[1][i], Sa_[1][i + 1]);   \
        mx = fmaxf(mx, Sa_[1][15]);                                                                   \
        mx = fmaxf(mx, __shfl_xor(mx, 32));                                                           \
        }                                                                                             \
        if ((kt_) == 0 && __any((mx > DEFER_THR) || (mx < -DEFER_THR))) {                             \
            const float mnew = bflo(pk2(m + mx, 0.f) & 0xffffu);                                      \
            const float delta = mnew - m;                                                             \
            const float alpha = ex2(-delta);                                                          \
            m = mnew; l *= alpha;                                                                     \
            q6 = hh ? 0u : (pk2(-mnew, 0.f) & 0xffffu);                                               \
            refnz = refnz || __any(mnew != 0.f);                                                      \
            _Pragma("unroll") for (int i = 0; i < 16; ++i) { O[0][i] *= alpha; O[1][i] *= alpha; Sa_[0][i] -= delta; Sa_[1][i] -= delta; } \
        }                                                                                             \
           \
        float lt_ = 0.f;                                                                              \
        {                                                                                             \
            const unsigned char* kl_ = lds + knext + koff;                                            \
            u32x4 q6v_ = {q6, 0u, 0u, 0u};                                                            \
            const bf16x8 q6f_ = __builtin_bit_cast(bf16x8, q6v_);                                     \
            if (refnz) { \
            { bf16x8 kfa_ = B_KFRAG(0, 7), kfb_ = B_KFRAG(1, 7), kfc_ = B_KFRAG(2, 7); \
            B_CHUNK(Sb_, 0, 7, kfa_) B_UNIT(Sa_, 0) B_UNIT(Sa_, 1) __builtin_amdgcn_sched_barrier(0); \
            B_CHUNK(Sb_, 1, 7, kfb_) B_UNIT(Sa_, 2) B_UNIT(Sa_, 3) __builtin_amdgcn_sched_barrier(0); \
            B_CHUNK(Sb_, 2, 7, kfc_) B_UNIT(Sa_, 4) __builtin_amdgcn_sched_barrier(0); \
            B_CHUNK(Sb_, 3, 7, kfa_) B_UNIT(Sa_, 5) __builtin_amdgcn_sched_barrier(0); \
            B_CHUNK(Sb_, 4, 7, kfb_) B_UNIT(Sa_, 6) __builtin_amdgcn_sched_barrier(0); \
            B_CHUNK(Sb_, 5, 7, kfc_) B_UNIT(Sa_, 7) __builtin_amdgcn_sched_barrier(0); \
            B_CHUNK(Sb_, 6, 7, kfa_) B_UNIT(Sa_, 8) __builtin_amdgcn_sched_barrier(0); \
            B_CHUNK(Sb_, 7, 7, kfb_) B_UNIT(Sa_, 9) __builtin_amdgcn_sched_barrier(0); \
            B_CHUNK(Sb_, 8, 7, kfc_) B_UNIT(Sa_, 10) __builtin_amdgcn_sched_barrier(0); \
            B_CHUNK(Sb_, 9, 7, kfa_) B_UNIT(Sa_, 11) __builtin_amdgcn_sched_barrier(0); \
            B_CHUNK(Sb_, 10, 7, kfb_) B_UNIT(Sa_, 12) __builtin_amdgcn_sched_barrier(0); \
            B_CHUNK(Sb_, 11, 7, kfc_) B_UNIT(Sa_, 13) __builtin_amdgcn_sched_barrier(0); \
            B_CHUNK(Sb_, 12, 7, kfa_) B_UNIT(Sa_, 14) __builtin_amdgcn_sched_barrier(0); \
            B_CHUNK(Sb_, 13, 7, kfb_) B_UNIT(Sa_, 15) __builtin_amdgcn_sched_barrier(0); \
            } \
            } else { \
            { bf16x8 kfa_ = B_KFRAG(0, 6), kfb_ = B_KFRAG(1, 6), kfc_ = B_KFRAG(2, 6); \
            B_CHUNK(Sb_, 0, 6, kfa_) B_UNIT(Sa_, 0) B_UNIT(Sa_, 1) __builtin_amdgcn_sched_barrier(0); \
            B_CHUNK(Sb_, 1, 6, kfb_) B_UNIT(Sa_, 2) B_UNIT(Sa_, 3) __builtin_amdgcn_sched_barrier(0); \
            B_CHUNK(Sb_, 2, 6, kfc_) B_UNIT(Sa_, 4) B_UNIT(Sa_, 5) __builtin_amdgcn_sched_barrier(0); \
            B_CHUNK(Sb_, 3, 6, kfa_) B_UNIT(Sa_, 6) B_UNIT(Sa_, 7) __builtin_amdgcn_sched_barrier(0); \
            B_CHUNK(Sb_, 4, 6, kfb_) B_UNIT(Sa_, 8) __builtin_amdgcn_sched_barrier(0); \
            B_CHUNK(Sb_, 5, 6, kfc_) B_UNIT(Sa_, 9) __builtin_amdgcn_sched_barrier(0); \
            B_CHUNK(Sb_, 6, 6, kfa_) B_UNIT(Sa_, 10) __builtin_amdgcn_sched_barrier(0); \
            B_CHUNK(Sb_, 7, 6, kfb_) B_UNIT(Sa_, 11) __builtin_amdgcn_sched_barrier(0); \
            B_CHUNK(Sb_, 8, 6, kfc_) B_UNIT(Sa_, 12) __builtin_amdgcn_sched_barrier(0); \
            B_CHUNK(Sb_, 9, 6, kfa_) B_UNIT(Sa_, 13) __builtin_amdgcn_sched_barrier(0); \
            B_CHUNK(Sb_, 10, 6, kfb_) B_UNIT(Sa_, 14) __builtin_amdgcn_sched_barrier(0); \
            B_CHUNK(Sb_, 11, 6, kfc_) B_UNIT(Sa_, 15) __builtin_amdgcn_sched_barrier(0); \
            } \
            } \
        }                                                                                             \
          \
        if (MODE != 3 && MODE != 4 && __any(!(lt_ <= 1.0995116e12f))) {                                \
            float mx2 = max3f(Sa_[0][0], Sa_[0][1], Sa_[0][2]);                                       \
            _Pragma("unroll") for (int i = 3; i < 15; i += 2) mx2 = max3f(mx2, Sa_[0][i], Sa_[0][i + 1]); \
            mx2 = max3f(mx2, Sa_[0][15], Sa_[1][0]);                                                   \
            _Pragma("unroll") for (int i = 1; i < 15; i += 2) mx2 = max3f(mx2, Sa_[1][i], Sa_[1][i + 1]); \
            mx2 = fmaxf(mx2, Sa_[1][15]);                                                             \
            mx2 = fmaxf(mx2, __shfl_xor(mx2, 32));                                                    \
            const float mnew = bflo(pk2(m + mx2, 0.f) & 0xffffu);                                     \
            const float delta = mnew - m;                                                             \
            const float alpha = ex2(-delta);                                                          \
            m = mnew; l *= alpha;                                                                     \
            q6 = hh ? 0u : (pk2(-mnew, 0.f) & 0xffffu);                                               \
            refnz = refnz || __any(mnew != 0.f);                                                      \
            lt_ = 0.f;                                                                                \
            _Pragma("unroll") for (int i = 0; i < 16; ++i) { O[0][i] *= alpha; O[1][i] *= alpha; Sb_[0][i] -= delta; Sb_[1][i] -= delta; } \
            _Pragma("unroll") for (int j = 0; j < 16; ++j) {                                          \
                const float e0_ = ex2(Sa_[j >> 3][2 * (j & 7)] - delta), e1_ = ex2(Sa_[j >> 3][2 * (j & 7) + 1] - delta); \
                lt_ += e0_; lt_ += e1_;                                                               \
                pw[j >> 3][(j >> 2) & 1][j & 3] = pk2(e0_, e1_);                                      \
            }                                                                                         \
        }                                                                                             \
        l += lt_;                                                                                     \
        }                                                                                             \
                                               \
        B_BARRIER(); \
        { const unsigned t_ = kcur; kcur = knext; knext = t_; }                                       \
        { const unsigned t_ = vprev; vprev = vcur; vcur = vnext; vnext = t_; }                        \
    }
        for (int kt = 0; kt < KV_NT; kt += 2) {
            B_ITER(S0, S1, kt)
            B_ITER(S1, S0, kt + 1)
        }
#undef B_ITER
#undef B_CHUNK
#undef B_KFRAG
#undef B_UNIT
        B_PV(vprev);
#undef B_DMA
#undef B_DMAP
#undef B_QK
#undef B_PV
        staged = has_next;
        if (MODE == 0) attn_store(O, l, sg, og, (size_t)(t0 + r) * 1024 + h * 64, hh);
        else { float acc_ = l + m; _Pragma("unroll") for (int i = 0; i < 16; ++i) acc_ += O[0][i] + O[1][i] + S0[0][i] + S0[1][i] + S1[0][i] + S1[1][i]; if (acc_ == 123.456f) og[0] = 0; }
        __syncthreads();
    }
    __builtin_amdgcn_s_setprio(0);
}

DI void final_norm_phase(const float* g, const bf16_t* x2b, float* out, int tid) {
    const int lane = tid & 63, gw = blockIdx.x * 8 + (tid >> 6), ngw = gridDim.x * 8;
    for (int row0 = gw; row0 < MLAT; row0 += 2 * ngw) {
        f32x4 v[2][4]; bool ok[2]; int row[2];
#pragma unroll
        for (int q = 0; q < 2; ++q) {
            row[q] = row0 + q * ngw; ok[q] = row[q] < MLAT;
            const bf16_t* src = x2b + (size_t)(ok[q] ? row[q] : row0) * D;
#pragma unroll
            for (int j = 0; j < 4; ++j) { const u32x2 b2 = *(const GAS u32x2*)(src + lane * 4 + 256 * j); v[q][j] = (f32x4){bflo(b2.x), bfhi(b2.x), bflo(b2.y), bfhi(b2.y)}; }
        }
#pragma unroll
        for (int q = 0; q < 2; ++q) {
            float ss = 0.f;
#pragma unroll
            for (int j = 0; j < 4; ++j) ss += (v[q][j].x * v[q][j].x + v[q][j].y * v[q][j].y) + (v[q][j].z * v[q][j].z + v[q][j].w * v[q][j].w);
            const float rstd = 1.f / sqrtf(wave_sum(ss) * (1.f / D) + EPS);
            if (ok[q]) {
#pragma unroll
                for (int j = 0; j < 4; ++j) { const f32x4 gg = *(const GAS f32x4*)(g + lane * 4 + 256 * j); *(GAS f32x4*)(out + (size_t)row[q] * D + lane * 4 + 256 * j) = v[q][j] * rstd * gg; }
            }
        }
    }
}

#define XB_TMO      128
#define XB_XCNT(j)  (256  + 64 * (j))
#define XB_XSUB(j)  (1280 + 64 * (j))
#define XB_XGEN(j)  (2304 + 64 * (j))
#define XB_TOP      3328
#define XB_TOPGEN   3392
#define XCD_BAR_WORDS 3456
#define XB_SPIN_CAP (1u << 18)
DI unsigned xb_ld(unsigned* p)              { return __hip_atomic_load(p, __ATOMIC_RELAXED, __HIP_MEMORY_SCOPE_AGENT); }
DI unsigned xb_add(unsigned* p, unsigned v) { return __hip_atomic_fetch_add(p, v, __ATOMIC_RELAXED, __HIP_MEMORY_SCOPE_AGENT); }
DI unsigned xb_xcc_id() { return (unsigned)__builtin_amdgcn_s_getreg((3 << 11) | 20) & 0xFu; }
#define XB_SPIN(cond, bar) do { unsigned _sp = 0; while (cond) { __builtin_amdgcn_s_sleep(1); \
    if ((++_sp & 255u) == 0u) { if (xb_ld(&(bar)[XB_TMO])) break; if (_sp > XB_SPIN_CAP) { atomicAdd(&(bar)[XB_TMO], 1u); break; } } } } while (0)
struct XcdBarrier { unsigned* bar; unsigned x; volatile LAS unsigned* st; };
DI XcdBarrier xcd_barrier_post(unsigned* bar, volatile LAS unsigned* st) {
    XcdBarrier b; b.bar = bar; b.x = xb_xcc_id(); b.st = st;
    if (threadIdx.x == 0) (void)xb_add(&bar[XB_XCNT(b.x)], 1u);
    return b;
}
DI void xcd_barrier_complete(unsigned* bar, unsigned x, unsigned& nloc, unsigned& nx) {
    const unsigned G = gridDim.x * gridDim.y * gridDim.z;
    unsigned sum, cnt, mine, sp = 0u;
    for (;;) {
        sum = 0u; cnt = 0u; mine = 0u;
#pragma unroll
        for (unsigned j = 0; j < 16; ++j) { const unsigned c = xb_ld(&bar[XB_XCNT(j)]); sum += c; cnt += (c > 0u) ? 1u : 0u; mine = (j == x) ? c : mine; }
        if (sum == G) break;
        __builtin_amdgcn_s_sleep(1);
        if ((++sp & 255u) == 0u) { if (xb_ld(&bar[XB_TMO])) break; if (sp > XB_SPIN_CAP) { atomicAdd(&bar[XB_TMO], 1u); break; } }
    }
    nloc = mine > 0u ? mine : 1u; nx = cnt > 0u ? cnt : 1u;
}
DI void xcd_barrier(const XcdBarrier& b) {
    asm volatile("s_waitcnt vmcnt(0)" ::: "memory");
    __syncthreads();
    if (threadIdx.x == 0) {
        unsigned* bar = b.bar;
        __builtin_amdgcn_s_waitcnt(0);
        unsigned nloc = b.st[0], nx = b.st[1];
        if (nloc == 0u) { xcd_barrier_complete(bar, b.x, nloc, nx); b.st[0] = nloc; b.st[1] = nx; }
        const unsigned old = xb_add(&bar[XB_XSUB(b.x)], 1u);
        const unsigned gen = old / nloc;
        if (old + 1u == (gen + 1u) * nloc) {
            __builtin_amdgcn_fence(__ATOMIC_RELEASE, "agent");
            asm volatile("s_waitcnt vmcnt(0)" ::: "memory");
            const unsigned og = xb_add(&bar[XB_TOP], 1u);
            const unsigned tg = og / nx;
            if (og + 1u == (tg + 1u) * nx) xb_add(&bar[XB_TOPGEN], 1u);
            else XB_SPIN(xb_ld(&bar[XB_TOPGEN]) == tg, bar);
            __builtin_amdgcn_fence(__ATOMIC_ACQUIRE, "agent");
            xb_add(&bar[XB_XGEN(b.x)], 1u);
            asm volatile("s_waitcnt vmcnt(0)" ::: "memory");
        } else {
            XB_SPIN(xb_ld(&bar[XB_XGEN(b.x)]) == gen, bar);
            __builtin_amdgcn_fence(__ATOMIC_ACQUIRE, "agent");
            asm volatile("s_waitcnt vmcnt(0)" ::: "memory");
        }
    }
    __syncthreads();
}

__device__ constexpr int PROBE_REP[12] = {1, 1, 1, 1, 1, 1, 1, 1, 1, 1, 1, 1};
#ifndef ONLY_PHASE
#define PH_SEL(k_) true
#else
#define PH_SEL(k_) ((k_) == ONLY_PHASE)
#endif
#define PH_BEGIN(k_) if (PH_SEL(k_) && p.ph_lo <= (k_) && (k_) < p.ph_hi) { unsigned char* ws = p.ws; float* out = p.out; int nrep_ = PROBE_REP[k_]; asm volatile("" : "+s"(ws), "+s"(out), "+s"(nrep_)); const float* mods = (const float*)(ws + WS_MODS); (void)mods; (void)out; for (int rep_ = 0; rep_ < nrep_; ++rep_) { if (rep_) __syncthreads();
#define PH_END(k_) } } if (p.ph_lo <= (k_) && (k_) + 1 < p.ph_hi) xcd_barrier(xb);
extern "C" __global__ void __launch_bounds__(512) mega_fwd(Params p) {
    extern __shared__ __attribute__((aligned(16))) unsigned char lds[];
    const int tid = threadIdx.x;
    __shared__ uint4 xb_words;
    if (tid == 0) xb_words = make_uint4(0u, 0u, 0u, 0u);
    __syncthreads();
    XcdBarrier xb; xb.bar = (unsigned*)(p.ws + WS_BAR); xb.x = 0; xb.st = (volatile LAS unsigned*)&xb_words;
    if (p.ph_hi - p.ph_lo > 1) xb = xcd_barrier_post((unsigned*)(p.ws + WS_BAR), (volatile LAS unsigned*)&xb_words);
    if (p.ph_lo < 0) cg::this_grid().sync();
    PH_BEGIN(0) phase0(p, ws, lds, tid); PH_END(0)
    PH_BEGIN(1) modulate_phase<false>(p.in[0], p.in[2], p.in[4], mods, (bf16_t*)(ws + WS_H), tid); PH_END(1)
    PH_BEGIN(2) EpiAin e{(bf16_t*)(ws + WS_Q0), (bf16_t*)(ws + WS_K0), (bf16_t*)(ws + WS_VT0), (bf16_t*)(ws + WS_SG), (const f32x2*)(ws + WS_ROPEA), lds + 65536 + (tid >> 6) * 2560};
        gemm_phase((const bf16_t*)(ws + WS_H), (const bf16_t*)(ws + WS_WT_IN0), MTOT / 256, 2560 / 256, 1024, e, lds, tid); PH_END(2)
    PH_BEGIN(3) attn_a_phase(p, ws, lds, tid); PH_END(3)
    PH_BEGIN(4) EpiWo0 e{p.in[0], (bf16_t*)out, p.in[2], (float*)(ws + WS_CTX1), mods};
        gemm_phase<EpiWo0, 2>((const bf16_t*)(ws + WS_OG0), (const bf16_t*)(ws + WS_WT_O0), MTOT / 128, 1024 / 256, 1024, e, lds, tid); PH_END(4)
    PH_BEGIN(5) modulate_phase<true>(out, (const float*)(ws + WS_CTX1), p.in[10], mods + 3 * 3072, (bf16_t*)(ws + WS_H), tid); PH_END(5)
    PH_BEGIN(6) EpiBin e{(bf16_t*)(ws + WS_CQN), (bf16_t*)(ws + WS_CKVN), (float*)(ws + WS_SSQ), ws + WS_KV, (const f32x2*)(ws + WS_ROPEB), (bf16_t*)(ws + WS_SG)};
        gemm_phase((const bf16_t*)(ws + WS_H), (const bf16_t*)(ws + WS_WT_IN1), MTOT / 256, 1536 / 256, 1024, e, lds, tid); PH_END(6)
    PH_BEGIN(8) EpiUq e{(bf16_t*)(ws + WS_Q1), (const f32x2*)(ws + WS_ROPEB), (const float*)(ws + WS_SSQ)};
        gemm_phase<EpiUq, 2>((const bf16_t*)(ws + WS_CQN), (const bf16_t*)(ws + WS_WT_UQ), MLAT / 128, 1536 / 256, 256, e, lds, tid);
        EpiUkv e2{ws + WS_KV, lds + 65536 + (tid >> 6) * 2560, (const float*)(ws + WS_SSQ)};
        gemm_phase<EpiUkv, 2>((const bf16_t*)(ws + WS_CKVN), (const bf16_t*)(ws + WS_WT_UKV), MTOT / 128, 2048 / 256, 128, e2, lds, tid); PH_END(8)
    PH_BEGIN(9) attn_b_phase<0>(ws, lds, tid); PH_END(9)
    PH_BEGIN(10) EpiWo1 e{(const bf16_t*)out, (bf16_t*)(ws + WS_Q1), mods + 3 * 3072};
        gemm_phase((const bf16_t*)(ws + WS_H), (const bf16_t*)(ws + WS_WT_O1), MLAT / 256, 1024 / 256, 1024, e, lds, tid); PH_END(10)
    PH_BEGIN(11) final_norm_phase(p.in[19], (const bf16_t*)(ws + WS_Q1), out, tid); PH_END(11)
}

extern "C" void kernel_launch(void* const* d_in, const int* in_sizes, int n_in, void* d_out, int out_size, void* d_ws, size_t ws_size, hipStream_t stream) {
    static int grid = 0;
    if (grid == 0) {
        if (n_in != 20 || ws_size < WS_END) { fprintf(stderr, "kernel_launch: unexpected n_in %d or ws_size %zu (< %zu)\n", n_in, ws_size, (size_t)WS_END); grid = -1; return; }
        int dev = 0, cus = 0, per_cu = 0;
        hipGetDevice(&dev);
        hipDeviceGetAttribute(&cus, hipDeviceAttributeMultiprocessorCount, dev);
        if (hipFuncSetAttribute((const void*)mega_fwd, hipFuncAttributeMaxDynamicSharedMemorySize, LDS_BYTES) != hipSuccess) { fprintf(stderr, "kernel_launch: hipFuncSetAttribute failed\n"); }
        if (hipOccupancyMaxActiveBlocksPerMultiprocessor(&per_cu, (const void*)mega_fwd, 512, LDS_BYTES) != hipSuccess || per_cu < 1) { fprintf(stderr, "kernel_launch: occupancy query says %d\n", per_cu); per_cu = 1; }
        (void)hipGetLastError();
        grid = cus * per_cu;
        if (grid <= 0) grid = 256;
    }
    if (grid < 0) return;
    Params p{};
    for (int i = 0; i < 20; ++i) p.in[i] = (const float*)d_in[i];
    p.out = (float*)d_out; p.ws = (unsigned char*)d_ws;
#if N_LAUNCH_MODE == 1
    p.ph_lo = 0; p.ph_hi = NPHASE;
    (void)hipMemsetAsync((unsigned char*)d_ws + WS_BAR, 0, 16384, stream);
    void* args[] = {&p};
    hipError_t e = hipLaunchCooperativeKernel((const void*)mega_fwd, dim3(grid), dim3(512), args, LDS_BYTES, stream);
    if (e != hipSuccess) fprintf(stderr, "cooperative launch failed: %s (grid %d)\n", hipGetErrorString(e), grid);
#else
    for (int ph = 0; ph < NPHASE; ++ph) {
        p.ph_lo = ph; p.ph_hi = ph + 1;
        hipLaunchKernelGGL(mega_fwd, dim3(grid), dim3(512), LDS_BYTES, stream, p);
    }
#endif
}
```

```cpp
#include <hip/hip_runtime.h>
#include <hip/hip_cooperative_groups.h>
#include <cstdio>
#include <cstdint>
namespace cg = cooperative_groups;

#ifndef N_LAUNCH_MODE
#define N_LAUNCH_MODE 1
#endif

typedef unsigned short bf16_t;
typedef short bf16x8 __attribute__((ext_vector_type(8)));
typedef float f32x16 __attribute__((ext_vector_type(16)));
typedef float f32x4 __attribute__((ext_vector_type(4)));
typedef float f32x2 __attribute__((ext_vector_type(2)));
typedef unsigned u32x4 __attribute__((ext_vector_type(4)));
typedef unsigned u32x2 __attribute__((ext_vector_type(2)));
typedef __bf16 bf16x2_t __attribute__((ext_vector_type(2)));

#define DI __device__ __forceinline__
#define GAS __attribute__((address_space(1)))
#define LAS __attribute__((address_space(3)))
#define MFMA(a, b, c) __builtin_amdgcn_mfma_f32_32x32x16_bf16((a), (b), (c), 0, 0, 0)

constexpr int D = 1024, SEQ = 8192, CTX = 256;
constexpr int MLAT = 2 * SEQ;
constexpr int MCTX = 2 * CTX;
constexpr int MTOT = MLAT + MCTX;
constexpr int KVKEYS = SEQ + CTX;
constexpr float EPS = 1e-6f;
constexpr float LOG2E = 1.4426950408889634f;
constexpr float QSCALE_A = 0.125f * 1.4426950408889634f;
constexpr float QSCALE_B = (float)(0.10206207261596575 * 1.4426950408889634);

constexpr size_t WS_MODS = 0;
constexpr size_t WS_ROPEA = WS_MODS + 2 * 3 * 3072 * 4;
constexpr size_t WS_ROPEB = WS_ROPEA + 128 * 16 * 8;
constexpr size_t WS_WT_IN0 = WS_ROPEB + 128 * 8 * 8;
constexpr size_t WS_WT_O0 = WS_WT_IN0 + (size_t)2560 * 1024 * 2;
constexpr size_t WS_WT_IN1 = WS_WT_O0 + (size_t)1024 * 1024 * 2;
constexpr size_t WS_WT_UQ = WS_WT_IN1 + (size_t)1536 * 1024 * 2;
constexpr size_t WS_WT_UKV = WS_WT_UQ + (size_t)1536 * 256 * 2;
constexpr size_t WS_WT_O1 = WS_WT_UKV + (size_t)2048 * 128 * 2;
constexpr size_t WS_CTX1 = WS_WT_O1 + (size_t)1024 * 1024 * 2;
constexpr size_t WS_H = WS_CTX1 + (size_t)MCTX * D * 4;
constexpr size_t WS_SG = WS_H + (size_t)MTOT * D * 2;
constexpr size_t WS_CQN = WS_SG + (size_t)MTOT * D * 2;
constexpr size_t WS_CKVN = WS_CQN + (size_t)MTOT * 256 * 2;
constexpr size_t WS_BIG = WS_CKVN + (size_t)MTOT * 128 * 2;
constexpr size_t WS_Q0 = WS_BIG;
constexpr size_t WS_K0 = WS_Q0 + (size_t)MTOT * D * 2;
constexpr size_t WS_VT0 = WS_K0 + (size_t)MTOT * 256 * 2;
constexpr size_t WS_OG0 = WS_VT0 + (size_t)2 * 256 * KVKEYS * 2;
constexpr size_t WS_Q1 = WS_BIG;
constexpr size_t WS_C416 = WS_BIG;
constexpr int KROW = 240;
constexpr int KV_VOFF = 64 * KROW;
constexpr int KV_TILE_BYTES = KV_VOFF + 64 * 144;
constexpr int KV_NT = KVKEYS / 64;
constexpr size_t WS_KV = WS_Q1 + (size_t)MLAT * 1536 * 2;
constexpr size_t WS_BAR = WS_KV + (size_t)32 * KV_NT * KV_TILE_BYTES;
constexpr size_t WS_SSQ = WS_BAR + 16384;
constexpr size_t WS_END = WS_SSQ + (size_t)2 * MTOT * 4;
static_assert(WS_END <= (size_t)256 * 1024 * 1024, "workspace map exceeds 256 MiB");

constexpr int LDS_BYTES = 131072 + 8 * 2560;
constexpr int NPHASE = 12;

struct Params {
    const float* in[20];
    float* out;
    unsigned char* ws;
    int ph_lo, ph_hi;
};

DI unsigned pk2(float a, float b) { f32x2 v = {a, b}; bf16x2_t r = __builtin_convertvector(v, bf16x2_t); return __builtin_bit_cast(unsigned, r); }
DI float bflo(unsigned u) { return __uint_as_float(u << 16); }
DI float bfhi(unsigned u) { return __uint_as_float(u & 0xffff0000u); }
DI float wave_sum(float v) {
#pragma unroll
    for (int o = 1; o < 64; o <<= 1) v += __shfl_xor(v, o);
    return v;
}
DI float silu_f(float v) { return v * __builtin_amdgcn_rcpf(1.f + __builtin_amdgcn_exp2f(-1.4426950408889634f * v)); }
DI float ex2(float v) { return __builtin_amdgcn_exp2f(v); }

DI void p0_transpose_unit(const float* W, int K, int N, int Npad, bf16_t* Wt, int r, float* tile, int tid, const float* kscale = nullptr) {
    const int ntn = Npad / 64, nt = r % ntn, kt = r / ntn, n0 = nt * 64, k0 = kt * 64;
#pragma unroll
    for (int j = 0; j < 8; ++j) {
        const int kk = (tid >> 6) + 8 * j, nn = tid & 63, n = n0 + nn;
        tile[kk * 65 + nn] = (n < N) ? W[(size_t)(k0 + kk) * N + n] * (kscale ? kscale[k0 + kk] : 1.f) : 0.f;
    }
    __syncthreads();
    {
        const int nn = tid >> 3, kk8 = (tid & 7) * 8;
        u32x4 o;
        o.x = pk2(tile[(kk8 + 0) * 65 + nn], tile[(kk8 + 1) * 65 + nn]);
        o.y = pk2(tile[(kk8 + 2) * 65 + nn], tile[(kk8 + 3) * 65 + nn]);
        o.z = pk2(tile[(kk8 + 4) * 65 + nn], tile[(kk8 + 5) * 65 + nn]);
        o.w = pk2(tile[(kk8 + 6) * 65 + nn], tile[(kk8 + 7) * 65 + nn]);
        *(u32x4*)(Wt + (size_t)(n0 + nn) * K + k0 + kk8) = o;
    }
    __syncthreads();
}

DI void p0_ada_unit(const Params& p, unsigned char* ws, int u, float* lds, int tid) {
    const int l = u / 96, n0 = (u % 96) * 32;
    const float* W = p.in[l ? 11 : 5];
    const float* bias = p.in[l ? 12 : 6];
    float* sv = lds;
    float* red = lds + 3 * 1024;
    for (int e = tid; e < 3 * 1024; e += 512) {
        const int v = e >> 10, k = e & 1023;
        const float cv = (v < 2) ? p.in[1][v * 1024 + k] : p.in[3][k];
        sv[e] = silu_f(cv);
    }
    __syncthreads();
    const int col = tid & 31, kg = tid >> 5;
    float a0 = 0.f, a1 = 0.f, a2 = 0.f;
#pragma unroll 8
    for (int kk = 0; kk < 64; ++kk) {
        const int k = kg * 64 + kk;
        const float wv = W[(size_t)k * 3072 + n0 + col];
        a0 += sv[k] * wv; a1 += sv[1024 + k] * wv; a2 += sv[2048 + k] * wv;
    }
    red[(kg * 3 + 0) * 32 + col] = a0; red[(kg * 3 + 1) * 32 + col] = a1; red[(kg * 3 + 2) * 32 + col] = a2;
    __syncthreads();
    if (tid < 96) {
        const int v = tid >> 5, c2 = tid & 31;
        float s = bias[n0 + c2];
#pragma unroll
        for (int g = 0; g < 16; ++g) s += red[(g * 3 + v) * 32 + c2];
        ((float*)(ws + WS_MODS))[(l * 3 + v) * 3072 + n0 + c2] = s;
    }
    __syncthreads();
}

DI void phase0(const Params& p, unsigned char* ws, unsigned char* ldsb, int tid) {
    float* lds = (float*)ldsb;
    constexpr int U_ADA = 192, U_ROPE = 6;
    constexpr int U_IN0 = (2560 / 64) * (1024 / 64), U_O = (1024 / 64) * (1024 / 64), U_IN1 = (1536 / 64) * (1024 / 64),
                  U_UQ = (1536 / 64) * (256 / 64), U_UKV = (2048 / 64) * (128 / 64);
    constexpr int NU = U_ADA + U_ROPE + U_IN0 + U_O + U_IN1 + U_UQ + U_UKV + U_O;
    { float* ssq = (float*)(ws + WS_SSQ); for (int e = blockIdx.x * 512 + tid; e < 2 * MTOT; e += gridDim.x * 512) ssq[e] = 0.f; }
    for (int u = blockIdx.x; u < NU; u += gridDim.x) {
        int r = u;
        if (r < U_ADA) { p0_ada_unit(p, ws, r, lds, tid); continue; } r -= U_ADA;
        if (r < U_ROPE) {
            const int e = r * 512 + tid;
            if (e < 2048) { const int pos = e >> 4, j = e & 15; const float inv = powf(10000.f, -(float)j / 16.f); const float a = (float)pos * inv;
                ((f32x2*)(ws + WS_ROPEA))[e] = (f32x2){cosf(a), sinf(a)}; }
            else { const int e2 = e - 2048; const int pos = e2 >> 3, j = e2 & 7; const float inv = powf(10000.f, -(float)j / 8.f); const float a = (float)pos * inv;
                ((f32x2*)(ws + WS_ROPEB))[e2] = (f32x2){cosf(a), sinf(a)}; }
            continue;
        } r -= U_ROPE;
        if (r < U_IN0) { p0_transpose_unit(p.in[7], 1024, 2560, 2560, (bf16_t*)(ws + WS_WT_IN0), r, lds, tid); continue; } r -= U_IN0;
        if (r < U_O) { p0_transpose_unit(p.in[9], 1024, 1024, 1024, (bf16_t*)(ws + WS_WT_O0), r, lds, tid); continue; } r -= U_O;
        if (r < U_IN1) { p0_transpose_unit(p.in[13], 1024, 1440, 1536, (bf16_t*)(ws + WS_WT_IN1), r, lds, tid); continue; } r -= U_IN1;
        if (r < U_UQ) { p0_transpose_unit(p.in[15], 256, 1536, 1536, (bf16_t*)(ws + WS_WT_UQ), r, lds, tid, p.in[14]); continue; } r -= U_UQ;
        if (r < U_UKV) { p0_transpose_unit(p.in[17], 128, 2048, 2048, (bf16_t*)(ws + WS_WT_UKV), r, lds, tid, p.in[16]); continue; } r -= U_UKV;
        p0_transpose_unit(p.in[18], 1024, 1024, 1024, (bf16_t*)(ws + WS_WT_O1), r, lds, tid);
    }
}

template <bool LAT_BF16>
DI void modulate_phase(const float* xlat, const float* xctx, const float* g, const float* mods_l, bf16_t* h, int tid) {
    const int lane = tid & 63, gw = blockIdx.x * 8 + (tid >> 6), ngw = gridDim.x * 8;
    for (int row0 = gw; row0 < MTOT; row0 += 2 * ngw) {
        const float* src[2]; const float* md[2]; int row[2]; bool ok[2];
        f32x4 v[2][4];
#pragma unroll
        for (int q = 0; q < 2; ++q) {
            row[q] = row0 + q * ngw; ok[q] = row[q] < MTOT;
            const int rr = ok[q] ? row[q] : row0;
            if (rr < MLAT) { src[q] = xlat + (size_t)rr * D; md[q] = mods_l + (rr >> 13) * 3072; }
            else { src[q] = xctx + (size_t)(rr - MLAT) * D; md[q] = mods_l + 2 * 3072; }
#pragma unroll
            for (int j = 0; j < 4; ++j) {
                if (LAT_BF16 && rr < MLAT) {
                    const u32x2 b2 = *(const GAS u32x2*)((const bf16_t*)xlat + (size_t)rr * D + lane * 4 + 256 * j);
                    v[q][j] = (f32x4){bflo(b2.x), bfhi(b2.x), bflo(b2.y), bfhi(b2.y)};
                } else v[q][j] = *(const GAS f32x4*)(src[q] + lane * 4 + 256 * j);
            }
        }
#pragma unroll
        for (int q = 0; q < 2; ++q) {
            float ss = 0.f;
#pragma unroll
            for (int j = 0; j < 4; ++j) ss += (v[q][j].x * v[q][j].x + v[q][j].y * v[q][j].y) + (v[q][j].z * v[q][j].z + v[q][j].w * v[q][j].w);
            const float rstd = 1.f / sqrtf(wave_sum(ss) * (1.f / D) + EPS);
            if (ok[q]) {
#pragma unroll
                for (int j = 0; j < 4; ++j) {
                    const int k = lane * 4 + 256 * j;
                    const f32x4 gg = *(const GAS f32x4*)(g + k), sh = *(const GAS f32x4*)(md[q] + k), sc = *(const GAS f32x4*)(md[q] + 1024 + k);
                    const f32x4 o = (v[q][j] * rstd * gg) * (sc + 1.f) + sh;
                    u32x2 w; w.x = pk2(o.x, o.y); w.y = pk2(o.z, o.w);
                    *(GAS u32x2*)(h + (size_t)row[q] * D + k) = w;
                }
            }
        }
    }
}

template <class Epi, int TB = 4>
DI void gemm_phase(const bf16_t* A, const bf16_t* Wt, int Mtiles, int Ntiles, int K, const Epi& epi, unsigned char* lds, int tid) {
    constexpr int RM = 64 * TB;
    const int lane = tid & 63, w = tid >> 6, wt = w >> 2, wf = w & 3, r = lane & 31, hh = lane >> 5;
    const int wu = __builtin_amdgcn_readfirstlane(w);
    const int nk = K >> 6;
    const unsigned swz = (r >> 1) & 7;
    unsigned koff[4];
#pragma unroll
    for (int ks = 0; ks < 4; ++ks) koff[ks] = ((unsigned)(ks * 2 + hh) ^ swz) << 4;
    const int drow = 8 * w + (lane >> 3);
    const int dch = (lane & 7) ^ ((drow >> 1) & 7);
    const size_t dsrc = (size_t)drow * K + dch * 8;
#define G_DMA(kt_, st_)                                                                               \
    _Pragma("unroll") for (int j = 0; j < 4; ++j) {                                                    \
        if (j < TB) __builtin_amdgcn_global_load_lds((const GAS unsigned*)(Ag + (size_t)(j * 64) * K + (kt_) * 64), (LAS unsigned*)(lds + (st_) * 65536 + (j * 8 + wu) * 1024), 16, 0, 0); \
        __builtin_amdgcn_global_load_lds((const GAS unsigned*)(Wg + (size_t)(j * 64) * K + (kt_) * 64), (LAS unsigned*)(lds + (st_) * 65536 + 32768 + (j * 8 + wu) * 1024), 16, 0, 0); \
    }
#define G_BARRIER() { asm volatile("s_waitcnt vmcnt(0) lgkmcnt(0)" ::: "memory"); __builtin_amdgcn_s_barrier(); asm volatile("" ::: "memory"); }
    const int nx = (gridDim.x == 256) ? 8 : 1, xcd = blockIdx.x % nx, nslots = gridDim.x / nx;
    const int nloc = ((Mtiles - xcd + nx - 1) / nx) * Ntiles;
    int u = blockIdx.x / nx;
    const GAS bf16_t* Ag = (const GAS bf16_t*)A + dsrc;
    const GAS bf16_t* Wg = (const GAS bf16_t*)Wt + dsrc;
    if (u < nloc) {
        Ag = (const GAS bf16_t*)(A + (size_t)(xcd + nx * (u / Ntiles)) * RM * K) + dsrc; Wg = (const GAS bf16_t*)(Wt + (size_t)(u % Ntiles) * 256 * K) + dsrc;
        G_DMA(0, 0);
        G_BARRIER();
    }
    while (u < nloc) {
        const int nt = u % Ntiles, mt = xcd + nx * (u / Ntiles);
        const int un = u + nslots;
        f32x16 acc[2][TB];
#pragma unroll
        for (int a = 0; a < 2; ++a)
#pragma unroll
            for (int b = 0; b < TB; ++b)
#pragma unroll
                for (int i = 0; i < 16; ++i) acc[a][b][i] = 0.f;
        for (int kt = 0; kt < nk; ++kt) {
            if (kt + 1 < nk) { G_DMA(kt + 1, (kt + 1) & 1); }
            else if (un < nloc) {
                Ag = (const GAS bf16_t*)(A + (size_t)(xcd + nx * (un / Ntiles)) * RM * K) + dsrc; Wg = (const GAS bf16_t*)(Wt + (size_t)(un % Ntiles) * 256 * K) + dsrc;
                G_DMA(0, 0);
            }
            const unsigned char* sa = lds + (kt & 1) * 65536 + (wt * 32 * TB + r) * 128;
            const unsigned char* sw = lds + (kt & 1) * 65536 + 32768 + (wf * 64 + r) * 128;
#pragma unroll
            for (int ks = 0; ks < 4; ++ks) {
                bf16x8 wfr[2], afr[TB];
#pragma unroll
                for (int fb = 0; fb < 2; ++fb) wfr[fb] = *(const bf16x8*)(sw + fb * 4096 + koff[ks]);
#pragma unroll
                for (int tb = 0; tb < TB; ++tb) afr[tb] = *(const bf16x8*)(sa + tb * 4096 + koff[ks]);
#pragma unroll
                for (int fb = 0; fb < 2; ++fb)
#pragma unroll
                    for (int tb = 0; tb < TB; ++tb) acc[fb][tb] = MFMA(wfr[fb], afr[tb], acc[fb][tb]);
            }
            G_BARRIER();
        }
#pragma unroll
        for (int fb = 0; fb < 2; ++fb)
#pragma unroll
            for (int tb = 0; tb < TB; ++tb) epi(nt * 256 + wf * 64 + fb * 32, mt * RM + wt * 32 * TB + tb * 32, acc[fb][tb], r, hh);
        u = un;
    }
    asm volatile("s_waitcnt vmcnt(0)" ::: "memory");
#undef G_DMA
#undef G_BARRIER
}

DI void store_bf16x4(bf16_t* dst, float a, float b, float c, float d) { u32x2 w; w.x = pk2(a, b); w.y = pk2(c, d); *(GAS u32x2*)dst = w; }
DI void store_bf16_row32(bf16_t* rowp, const float (&v)[16], int hh) {
#pragma unroll
    for (int p = 0; p < 2; ++p) {
        unsigned ax = pk2(v[8 * p + 0], v[8 * p + 1]), ay = pk2(v[8 * p + 2], v[8 * p + 3]);
        unsigned bx = pk2(v[8 * p + 4], v[8 * p + 5]), by = pk2(v[8 * p + 6], v[8 * p + 7]);
        const auto rx = __builtin_amdgcn_permlane32_swap(ax, bx, false, false);
        const auto ry = __builtin_amdgcn_permlane32_swap(ay, by, false, false);
        u32x4 w; w.x = rx[0]; w.y = ry[0]; w.z = rx[1]; w.w = ry[1];
        *(GAS u32x4*)(rowp + 16 * p + 8 * hh) = w;
    }
}
DI void store_bf16_tr32(bf16_t* out, size_t ld, const f32x16& acc, unsigned char* patch, int r, int hh) {
#pragma unroll
    for (int i = 0; i < 16; ++i) { const int f = (i & 3) + 8 * (i >> 2) + 4 * hh; *(bf16_t*)(patch + f * 80 + r * 2) = (bf16_t)(pk2(acc[i], 0.f) & 0xffffu); }
    const int lane = r + 32 * hh;
#pragma unroll
    for (int q = 0; q < 2; ++q) {
        const int ch = lane + 64 * q, f = ch >> 2, tc = ch & 3;
        const u32x4 wv = *(const u32x4*)(patch + f * 80 + tc * 16);
        *(GAS u32x4*)(out + (size_t)f * ld + tc * 8) = wv;
    }
}
DI void store_bf16(bf16_t* dst, float a) { *(GAS bf16_t*)dst = (bf16_t)(pk2(a, 0.f) & 0xffffu); }

struct EpiNull {
    float* sink;
    DI void operator()(int fbase, int tbase, const f32x16& acc, int r, int hh) const {
        float s = 0.f;
#pragma unroll
        for (int i = 0; i < 16; ++i) s += acc[i];
        if (s == 123.456f) sink[0] = s;
    }
};
struct EpiAin {
    bf16_t* q0; bf16_t* k0; bf16_t* vt0; bf16_t* sg; const f32x2* ropeA; unsigned char* patch;
    DI void operator()(int fbase, int tbase, const f32x16& acc, int r, int hh) const {
        const int t = tbase + r;
        const bool latent = t < MLAT;
        if (fbase < 1280) {
            f32x16 v = acc;
            if (latent) {
                const int pos = t & (SEQ - 1);
                const int pp = (fbase & 32) ? (pos & 63) : (pos >> 6);
                const f32x2* tab = ropeA + pp * 16;
#pragma unroll
                for (int i = 0; i < 8; ++i) {
                    const int j = (i & 3) + 8 * (i >> 2) + 4 * hh;
                    const f32x2 cs = tab[j];
                    const float a = acc[i], b = acc[i + 8];
                    v[i] = a * cs.x - b * cs.y; v[i + 8] = b * cs.x + a * cs.y;
                }
            }
            float o[16];
            if (fbase < 1024) {
#pragma unroll
                for (int i = 0; i < 16; ++i) o[i] = v[i] * QSCALE_A;
                store_bf16_row32(q0 + (size_t)t * 1024 + fbase, o, hh);
            } else {
#pragma unroll
                for (int i = 0; i < 16; ++i) o[i] = v[i];
                store_bf16_row32(k0 + (size_t)t * 256 + (fbase - 1024), o, hh);
            }
        } else if (fbase < 1536) {
            const int f0 = fbase - 1280;
            int b, key;
            if (latent) { b = t >> 13; key = t & (SEQ - 1); } else { const int tc = t - MLAT; b = tc >> 8; key = SEQ + (tc & 255); }
            store_bf16_tr32(vt0 + (size_t)(b * 256 + f0) * KVKEYS + (key - r), KVKEYS, acc, patch, r, hh);
        } else {
            float o[16];
#pragma unroll
            for (int i = 0; i < 16; ++i) o[i] = silu_f(acc[i]);
            store_bf16_row32(sg + (size_t)t * 1024 + (fbase - 1536), o, hh);
        }
    }
};

struct EpiWo0 {
    const float* xres; bf16_t* xb; const float* cres; float* cdst; const float* mods_l;
    DI void operator()(int fbase, int tbase, const f32x16& acc, int r, int hh) const {
        const int t = tbase + r;
        if (t < MLAT) {
            const float* res = xres + (size_t)t * D; const float* gate = mods_l + (t >> 13) * 3072 + 2048;
            float o[16];
#pragma unroll
            for (int g = 0; g < 4; ++g) {
                const int f = fbase + 8 * g + 4 * hh;
                const f32x4 rr = *(const GAS f32x4*)(res + f), gg = *(const GAS f32x4*)(gate + f);
                o[4 * g] = rr.x + gg.x * acc[4 * g]; o[4 * g + 1] = rr.y + gg.y * acc[4 * g + 1]; o[4 * g + 2] = rr.z + gg.z * acc[4 * g + 2]; o[4 * g + 3] = rr.w + gg.w * acc[4 * g + 3];
            }
            store_bf16_row32(xb + (size_t)t * D + fbase, o, hh);
        } else {
            const float* res = cres + (size_t)(t - MLAT) * D; float* dst = cdst + (size_t)(t - MLAT) * D; const float* gate = mods_l + 2 * 3072 + 2048;
#pragma unroll
            for (int g = 0; g < 4; ++g) {
                const int f = fbase + 8 * g + 4 * hh;
                const f32x4 rr = *(const GAS f32x4*)(res + f), gg = *(const GAS f32x4*)(gate + f);
                f32x4 o; o.x = rr.x + gg.x * acc[4 * g]; o.y = rr.y + gg.y * acc[4 * g + 1]; o.z = rr.z + gg.z * acc[4 * g + 2]; o.w = rr.w + gg.w * acc[4 * g + 3];
                *(GAS f32x4*)(dst + f) = o;
            }
        }
    }
};
struct EpiWo1 {
    const bf16_t* xb; bf16_t* x2b; const float* mods_l;
    DI void operator()(int fbase, int tbase, const f32x16& acc, int r, int hh) const {
        const int t = tbase + r;
        const bf16_t* res = xb + (size_t)t * D; const float* gate = mods_l + (t >> 13) * 3072 + 2048;
        float o[16];
#pragma unroll
        for (int g = 0; g < 4; ++g) {
            const int f = fbase + 8 * g + 4 * hh;
            const u32x2 rb = *(const GAS u32x2*)(res + f); const f32x4 gg = *(const GAS f32x4*)(gate + f);
            o[4 * g] = bflo(rb.x) + gg.x * acc[4 * g]; o[4 * g + 1] = bfhi(rb.x) + gg.y * acc[4 * g + 1]; o[4 * g + 2] = bflo(rb.y) + gg.z * acc[4 * g + 2]; o[4 * g + 3] = bfhi(rb.y) + gg.w * acc[4 * g + 3];
        }
        store_bf16_row32(x2b + (size_t)t * D + fbase, o, hh);
    }
};

struct EpiBin {
    bf16_t* cq; bf16_t* ckv; float* ssq; unsigned char* kv; const f32x2* ropeB; bf16_t* sg;
    DI void operator()(int fbase, int tbase, const f32x16& acc, int r, int hh) const {
        const int t = tbase + r;
        if (fbase < 384) {
            float o[16]; float s = 0.f;
#pragma unroll
            for (int i = 0; i < 16; ++i) { o[i] = acc[i]; s += acc[i] * acc[i]; }
            s += __shfl_xor(s, 32);
            if (fbase < 256) { store_bf16_row32(cq + (size_t)t * 256 + fbase, o, hh); if (hh == 0) atomicAdd(ssq + t, s); }
            else { store_bf16_row32(ckv + (size_t)t * 128 + (fbase - 256), o, hh); if (hh == 0) atomicAdd(ssq + MTOT + t, s); }
        } else if (fbase < 416) {
            float o[16];
            int b, key;
            if (t < MLAT) {
                b = t >> 13; key = t & (SEQ - 1);
                const f32x2* tr = ropeB + (key >> 6) * 8 + 4 * hh;
                const f32x2* tc = ropeB + (key & 63) * 8 + 4 * hh;
#pragma unroll
                for (int i = 0; i < 4; ++i) {
                    const f32x2 c1 = tr[i]; const float a = acc[i], b2 = acc[i + 4];
                    o[i] = a * c1.x - b2 * c1.y; o[i + 4] = b2 * c1.x + a * c1.y;
                    const f32x2 c2 = tc[i]; const float a2 = acc[i + 8], b3 = acc[i + 12];
                    o[i + 8] = a2 * c2.x - b3 * c2.y; o[i + 12] = b3 * c2.x + a2 * c2.y;
                }
            } else {
                const int tc2 = t - MLAT; b = tc2 >> 8; key = SEQ + (tc2 & 255);
#pragma unroll
                for (int i = 0; i < 16; ++i) o[i] = acc[i];
            }
            unsigned char* base = kv + ((size_t)(b * 16) * KV_NT + (key >> 6)) * KV_TILE_BYTES + (key & 63) * KROW + 128;
#pragma unroll
            for (int p = 0; p < 2; ++p) {
                unsigned ax = pk2(o[8 * p + 0], o[8 * p + 1]), ay = pk2(o[8 * p + 2], o[8 * p + 3]);
                unsigned bx = pk2(o[8 * p + 4], o[8 * p + 5]), by = pk2(o[8 * p + 6], o[8 * p + 7]);
                const auto rx = __builtin_amdgcn_permlane32_swap(ax, bx, false, false);
                const auto ry = __builtin_amdgcn_permlane32_swap(ay, by, false, false);
                u32x4 wv; wv.x = rx[0]; wv.y = ry[0]; wv.z = rx[1]; wv.w = ry[1];
#pragma unroll
                for (int hd = 0; hd < 16; ++hd) *(GAS u32x4*)(base + (size_t)hd * KV_NT * KV_TILE_BYTES + (16 * p + 8 * hh) * 2) = wv;
            }
        } else if (fbase < 1440) {
            float o[16];
#pragma unroll
            for (int i = 0; i < 16; ++i) o[i] = silu_f(acc[i]);
            store_bf16_row32(sg + (size_t)t * 1024 + (fbase - 416), o, hh);
        }
    }
};

struct EpiUq {
    bf16_t* q1; const f32x2* ropeB; const float* ssq;
    DI void operator()(int fbase, int tbase, const f32x16& acc, int r, int hh) const {
        const int t = tbase + r;
        f32x16 v = acc;
        if (((fbase >> 5) % 3) == 2) {
            const int pos = t & (SEQ - 1);
            const f32x2* tr = ropeB + (pos >> 6) * 8 + 4 * hh;
            const f32x2* tc = ropeB + (pos & 63) * 8 + 4 * hh;
#pragma unroll
            for (int i = 0; i < 4; ++i) {
                const f32x2 c1 = tr[i]; const float a = acc[i], b = acc[i + 4];
                v[i] = a * c1.x - b * c1.y; v[i + 4] = b * c1.x + a * c1.y;
                const f32x2 c2 = tc[i]; const float a2 = acc[i + 8], b2 = acc[i + 12];
                v[i + 8] = a2 * c2.x - b2 * c2.y; v[i + 12] = b2 * c2.x + a2 * c2.y;
            }
        }
        const float rs = QSCALE_B / sqrtf(ssq[t] * (1.f / 256.f) + EPS);
        float o[16];
#pragma unroll
        for (int i = 0; i < 16; ++i) o[i] = v[i] * rs;
        store_bf16_row32(q1 + (size_t)t * 1536 + fbase, o, hh);
    }
};

struct EpiUkv {
    unsigned char* kv; unsigned char* patch; const float* ssq;
    DI void operator()(int fbase, int tbase, const f32x16& acc, int r, int hh) const {
        const int t = tbase + r;
        const int head = fbase >> 7, dd0 = fbase & 127;
        int b, key;
        if (t < MLAT) { b = t >> 13; key = t & (SEQ - 1); } else { const int tc = t - MLAT; b = tc >> 8; key = SEQ + (tc & 255); }
        unsigned char* base = kv + ((size_t)(b * 16 + head) * KV_NT + (key >> 6)) * KV_TILE_BYTES;
        const int kin = key & 63;
        const float rs = 1.f / sqrtf(ssq[MTOT + t] * (1.f / 128.f) + EPS);
        if (dd0 < 64) {
            float o[16];
#pragma unroll
            for (int i = 0; i < 16; ++i) o[i] = acc[i] * rs;
            store_bf16_row32((bf16_t*)(base + kin * KROW) + dd0, o, hh);
        } else {
            f32x16 sv = acc * rs;
            store_bf16_tr32((bf16_t*)(base + KV_VOFF + (dd0 - 64) * 144) + (kin - r), 72, sv, patch, r, hh);
        }
    }
};

DI void prep_b_phase(const Params& p, unsigned char* ws, int tid) {
    const int lane = tid & 63, gw = blockIdx.x * 8 + (tid >> 6), ngw = gridDim.x * 8;
    const float* c416 = (const float*)(ws + WS_C416);
    bf16_t* cqn = (bf16_t*)(ws + WS_CQN);
    bf16_t* ckvn = (bf16_t*)(ws + WS_CKVN);
    const f32x2* ropeB = (const f32x2*)(ws + WS_ROPEB);
    const float* qg = p.in[14]; const float* kvg = p.in[16];
    for (int t = gw; t < MTOT; t += ngw) {
        const float* c = c416 + (size_t)t * 416;
        const f32x4 a = *(const f32x4*)(c + lane * 4);
        const float s1 = wave_sum((a.x * a.x + a.y * a.y) + (a.z * a.z + a.w * a.w));
        const float r1 = 1.f / sqrtf(s1 * (1.f / 256.f) + EPS);
        const f32x4 g1 = *(const f32x4*)(qg + lane * 4);
        store_bf16x4(cqn + (size_t)t * 256 + lane * 4, a.x * r1 * g1.x, a.y * r1 * g1.y, a.z * r1 * g1.z, a.w * r1 * g1.w);
        const f32x2 bq = *(const f32x2*)(c + 256 + lane * 2);
        const float s2 = wave_sum(bq.x * bq.x + bq.y * bq.y);
        const float r2 = 1.f / sqrtf(s2 * (1.f / 128.f) + EPS);
        const f32x2 g2 = *(const f32x2*)(kvg + lane * 2);
        *(unsigned*)(ckvn + (size_t)t * 128 + lane * 2) = pk2(bq.x * r2 * g2.x, bq.y * r2 * g2.y);
        {
            const int hd = lane >> 2, cc = lane & 3;
            const f32x4 xa = *(const GAS f32x4*)(c + 384 + 8 * cc), xb = *(const GAS f32x4*)(c + 384 + 8 * cc + 4);
            const f32x4 ya = *(const GAS f32x4*)(c + 384 + 8 * (cc ^ 1)), yb = *(const GAS f32x4*)(c + 384 + 8 * (cc ^ 1) + 4);
            float xo[8] = {xa.x, xa.y, xa.z, xa.w, xb.x, xb.y, xb.z, xb.w};
            const float yo[8] = {ya.x, ya.y, ya.z, ya.w, yb.x, yb.y, yb.z, yb.w};
            int b, key;
            if (t < MLAT) {
                b = t >> 13; key = t & (SEQ - 1);
                const int pp = (cc < 2) ? (key >> 6) : (key & 63);
                const float sgn = (cc & 1) ? 1.f : -1.f;
#pragma unroll
                for (int j = 0; j < 8; ++j) { const f32x2 cs = ropeB[pp * 8 + j]; xo[j] = xo[j] * cs.x + sgn * yo[j] * cs.y; }
            } else { const int tc = t - MLAT; b = tc >> 8; key = SEQ + (tc & 255); }
            u32x4 wv; wv.x = pk2(xo[0], xo[1]); wv.y = pk2(xo[2], xo[3]); wv.z = pk2(xo[4], xo[5]); wv.w = pk2(xo[6], xo[7]);
            unsigned char* dst = ws + WS_KV + ((size_t)(b * 16 + hd) * KV_NT + (key >> 6)) * KV_TILE_BYTES + (key & 63) * KROW + (64 + 8 * cc) * 2;
            *(GAS u32x4*)dst = wv;
        }
    }
}

DI float max3f_(float a, float b, float c) { return fmaxf(fmaxf(a, b), c); }
DI void softmax_pv(f32x16 (&S)[2], f32x16 (&O)[2], float& m, float& l, const unsigned char* vl, int r, int hh) {
    float e[2][16];
    float lt = 0.f;
#pragma unroll
    for (int sb = 0; sb < 2; ++sb)
#pragma unroll
        for (int i = 0; i < 16; ++i) { e[sb][i] = ex2(S[sb][i] - m); lt += e[sb][i]; }
    if (__any(!(lt <= 1.0995116e12f))) {
        float mx = max3f_(S[0][0], S[0][1], S[0][2]);
#pragma unroll
        for (int i = 3; i < 15; i += 2) mx = max3f_(mx, S[0][i], S[0][i + 1]);
        mx = max3f_(mx, S[0][15], S[1][0]);
#pragma unroll
        for (int i = 1; i < 15; i += 2) mx = max3f_(mx, S[1][i], S[1][i + 1]);
        mx = fmaxf(mx, S[1][15]);
        mx = fmaxf(mx, __shfl_xor(mx, 32));
        const float mn = fmaxf(m, mx), alpha = ex2(m - mn);
        m = mn; l *= alpha; lt = 0.f;
#pragma unroll
        for (int i = 0; i < 16; ++i) { O[0][i] *= alpha; O[1][i] *= alpha; }
#pragma unroll
        for (int sb = 0; sb < 2; ++sb)
#pragma unroll
            for (int i = 0; i < 16; ++i) { e[sb][i] = ex2(S[sb][i] - mn); lt += e[sb][i]; }
    }
    l += lt;
#pragma unroll
    for (int sb = 0; sb < 2; ++sb)
#pragma unroll
        for (int s = 0; s < 2; ++s) {
            u32x4 pw;
            pw.x = pk2(e[sb][8 * s + 0], e[sb][8 * s + 1]); pw.y = pk2(e[sb][8 * s + 2], e[sb][8 * s + 3]);
            pw.z = pk2(e[sb][8 * s + 4], e[sb][8 * s + 5]); pw.w = pk2(e[sb][8 * s + 6], e[sb][8 * s + 7]);
            const bf16x8 pf = __builtin_bit_cast(bf16x8, pw);
#pragma unroll
            for (int db = 0; db < 2; ++db) {
                const bf16x8 vf = *(const bf16x8*)(vl + (db * 32 + r) * 144 + (sb * 32 + s * 16 + hh * 8) * 2);
                O[db] = MFMA(vf, pf, O[db]);
            }
        }
}

DI void attn_store(const f32x16 (&O)[2], float l, const bf16_t* sg, bf16_t* og, size_t rowoff, int hh) {
    const float lt = l + __shfl_xor(l, 32);
    const float inv = 1.f / lt;
#pragma unroll
    for (int db = 0; db < 2; ++db) {
        float o[16];
#pragma unroll
        for (int g = 0; g < 4; ++g) {
            const size_t idx = rowoff + db * 32 + 8 * g + 4 * hh;
            const u32x2 sv = *(const GAS u32x2*)(sg + idx);
            o[4 * g] = O[db][4 * g] * inv * bflo(sv.x); o[4 * g + 1] = O[db][4 * g + 1] * inv * bfhi(sv.x);
            o[4 * g + 2] = O[db][4 * g + 2] * inv * bflo(sv.y); o[4 * g + 3] = O[db][4 * g + 3] * inv * bfhi(sv.y);
        }
        store_bf16_row32(og + rowoff + db * 32, o, hh);
    }
}

DI void attn_a_phase(const Params& p, unsigned char* ws, unsigned char* lds, int tid) {
    const int lane = tid & 63, w = tid >> 6, r = lane & 31, hh = lane >> 5;
    const int pr = (r & ~12) | ((r & 4) << 1) | ((r & 8) >> 1);
    const int qs = w & 3, hp = w >> 2;
    const bf16_t* q0 = (const bf16_t*)(ws + WS_Q0);
    const bf16_t* k0 = (const bf16_t*)(ws + WS_K0);
    const bf16_t* vt0 = (const bf16_t*)(ws + WS_VT0);
    const bf16_t* sg = (const bf16_t*)(ws + WS_SG);
    bf16_t* og = (bf16_t*)(ws + WS_OG0);
    const float* sinks = p.in[8];
    const int lrow = tid >> 3, lch = tid & 7;
    for (int round = 0;; ++round) {
        int u;
        if (gridDim.x == 256) {
            const int j = blockIdx.x;
            if (round == 0) u = j; else if (round == 1) u = (j < 16) ? 496 + j : 240 + j; else if (round == 2 && j < 16) u = 512 + j; else break;
        } else { u = blockIdx.x + round * gridDim.x; if (u >= 528) break; }
        int b, kvh, iblk, tq0, ntiles, ploc0;
        bool latent;
        if (u < 512) {
            latent = true;
            if (u < 496) { b = u / 248; const int rem = u % 248; iblk = 1 + (rem >> 2); kvh = rem & 3; }
            else { const int li = u - 496; b = li >> 3; iblk = ((li >> 2) & 1) ? 63 : 0; kvh = li & 3; }
            tq0 = b * SEQ + iblk * 128 + qs * 32;
            ploc0 = (iblk > 0) ? (iblk - 1) * 128 : 0; const int pend = (iblk < 63) ? (iblk + 2) * 128 : SEQ; ntiles = 4 + ((pend - ploc0) >> 6); }
        else { const int uc = u - 512; latent = false; b = uc >> 3; iblk = 0; kvh = uc & 3; tq0 = MLAT + b * CTX + ((uc >> 2) & 1) * 128 + qs * 32; ploc0 = 0; ntiles = 4; }
        const int hd0 = kvh * 4 + hp * 2;
        bf16x8 qf[2][4];
#pragma unroll
        for (int e = 0; e < 2; ++e)
#pragma unroll
            for (int ks = 0; ks < 4; ++ks) qf[e][ks] = *(const bf16x8*)(q0 + (size_t)(tq0 + r) * 1024 + (hd0 + e) * 64 + ks * 16 + hh * 8);
        f32x16 O[2][2];
        float m[2], l[2];
#pragma unroll
        for (int e = 0; e < 2; ++e) {
            m[e] = sinks[hd0 + e] * LOG2E; l[e] = hh ? 0.f : 1.f;
#pragma unroll
            for (int i = 0; i < 16; ++i) { O[e][0][i] = 0.f; O[e][1][i] = 0.f; }
        }
        const int qlo = iblk * 128 + qs * 32;
        u32x4 rk, rv;
#define A_LOAD(ti_)                                                                                             \
    {                                                                                                           \
        int ktok0_, vkey0_;                                                                                     \
        if ((ti_) < 4) { ktok0_ = MLAT + b * CTX + (ti_) * 64; vkey0_ = SEQ + (ti_) * 64; }                     \
        else { const int p0_ = ploc0 + ((ti_) - 4) * 64; ktok0_ = b * SEQ + p0_; vkey0_ = p0_; }                \
        rk = *(const GAS u32x4*)(const void*)(k0 + (size_t)(ktok0_ + lrow) * 256 + kvh * 64 + lch * 8);        \
        rv = *(const GAS u32x4*)(const void*)(vt0 + (size_t)(b * 256 + kvh * 64 + lrow) * KVKEYS + vkey0_ + lch * 8); \
    }
#define A_STORE(st_)                                                                                            \
    {                                                                                                           \
        unsigned char* sb_ = lds + (st_) * 18432 + lrow * 144 + lch * 16;                                       \
        *(u32x4*)sb_ = rk; *(u32x4*)(sb_ + 9216) = rv;                                                          \
    }
        A_LOAD(0);
        A_STORE(0);
        __syncthreads();
        for (int ti = 0; ti < ntiles; ++ti) {
            if (ti + 1 < ntiles) { A_LOAD(ti + 1); }
            const unsigned char* kl = lds + (ti & 1) * 18432;
            const unsigned char* vl = kl + 9216;
            const bool masked = ti >= 4;
            const int kpos0 = ploc0 + (ti - 4) * 64;
            const bool skip = masked && (kpos0 > qlo + 31 + 128 || kpos0 + 63 < qlo - 128);
            if (!skip) {
                f32x16 S[2][2];
#pragma unroll
                for (int e = 0; e < 2; ++e)
#pragma unroll
                    for (int sb = 0; sb < 2; ++sb)
#pragma unroll
                        for (int i = 0; i < 16; ++i) S[e][sb][i] = 0.f;
#pragma unroll
                for (int sb = 0; sb < 2; ++sb)
#pragma unroll
                    for (int ks = 0; ks < 4; ++ks) {
                        const bf16x8 kf = *(const bf16x8*)(kl + (sb * 32 + pr) * 144 + ks * 32 + hh * 16);
                        S[0][sb] = MFMA(kf, qf[0][ks], S[0][sb]);
                        S[1][sb] = MFMA(kf, qf[1][ks], S[1][sb]);
                    }
                if (masked && !(kpos0 >= qlo - 97 && kpos0 <= qlo + 65)) {
                    const int qp = qlo + r;
#pragma unroll
                    for (int sb = 0; sb < 2; ++sb)
#pragma unroll
                        for (int i = 0; i < 16; ++i) {
                            const int kp = kpos0 + sb * 32 + 16 * (i >> 3) + 8 * hh + (i & 7);
                            const int dlt = qp - kp;
                            if (dlt > 128 || dlt < -128) { S[0][sb][i] = -1e30f; S[1][sb][i] = -1e30f; }
                        }
                }
                softmax_pv(S[0], O[0], m[0], l[0], vl, r, hh);
                softmax_pv(S[1], O[1], m[1], l[1], vl, r, hh);
            }
            if (ti + 1 < ntiles) { A_STORE((ti + 1) & 1); }
            __syncthreads();
        }
#undef A_LOAD
#undef A_STORE
        (void)latent;
#pragma unroll
        for (int e = 0; e < 2; ++e) attn_store(O[e], l[e], sg, og, (size_t)(tq0 + r) * 1024 + (hd0 + e) * 64, hh);
    }
}

DI float max3f(float a, float b, float c) { return fmaxf(fmaxf(a, b), c); }
constexpr float DEFER_THR = 8.f;
constexpr int BK_OFF0 = 0, BV_OFF0 = 2 * KV_VOFF, BV_SZ = 64 * 144;
template <int MODE>
DI void attn_b_phase(unsigned char* ws, unsigned char* lds, int tid) {
    const int lane = tid & 63, w = tid >> 6, r = lane & 31, hh = lane >> 5;
    const int pr = (r & ~12) | ((r & 4) << 1) | ((r & 8) >> 1);
    const bf16_t* q1 = (const bf16_t*)(ws + WS_Q1);
    const bf16_t* sg = (const bf16_t*)(ws + WS_SG);
    bf16_t* og = (bf16_t*)(ws + WS_H);
    const int wu = __builtin_amdgcn_readfirstlane(w);
    const u32x4 konev = {hh ? 0u : 0x3F80u, 0u, 0u, 0u};
    const bf16x8 kone = __builtin_bit_cast(bf16x8, konev);
    const unsigned koff = pr * KROW + hh * 16;
    const unsigned voff = r * 144 + hh * 16;
    if (wu >= 4) __builtin_amdgcn_s_setprio(1);
    bool staged = false;
    for (int it = 0;; ++it) {
        const int u = blockIdx.x + it * gridDim.x;
        if (u >= 1024) break;
        int bh, qt;
        if (gridDim.x == 256) { bh = it * 8 + (blockIdx.x & 7); qt = blockIdx.x >> 3; } else { bh = u >> 5; qt = u & 31; }
        const int b = bh >> 4, h = bh & 15;
        const int t0 = b * SEQ + qt * 256 + w * 32;
        bf16x8 qf[6];
#pragma unroll
        for (int ks = 0; ks < 6; ++ks) qf[ks] = *(const bf16x8*)(q1 + (size_t)(t0 + r) * 1536 + h * 96 + ks * 16 + hh * 8);
        f32x16 O[2];
#pragma unroll
        for (int i = 0; i < 16; ++i) { O[0][i] = 0.f; O[1][i] = 0.f; }
        float m = 0.f, l = 0.f;
        unsigned q6 = 0u;
        bool refnz = false;
        const GAS unsigned char* kvb = (const GAS unsigned char*)(ws + WS_KV + (size_t)bh * KV_NT * KV_TILE_BYTES);
        const bool has_next = u + (int)gridDim.x < 1024;
        const int bh_next = has_next ? ((gridDim.x == 256) ? (it + 1) * 8 + (blockIdx.x & 7) : (u + (int)gridDim.x) >> 5) : bh;
        const GAS unsigned char* kvn = (const GAS unsigned char*)(ws + WS_KV + (size_t)bh_next * KV_NT * KV_TILE_BYTES);
#define B_DMAP(kp_, vp_, ko_, vo_)     \
    {                                                                                                 \
        const GAS unsigned char* sk_ = (kp_) + lane * 16;                                             \
        const GAS unsigned char* sv_ = (vp_) + lane * 16;                                             \
        const GAS unsigned char* s1_ = (wu < 7) ? sk_ + (8 + wu) * 1024 : sv_ + 15 * 1024;            \
        const unsigned d1_ = (wu < 7) ? (ko_) + (8 + wu) * 1024 : (vo_);                              \
        __builtin_amdgcn_global_load_lds((const GAS unsigned*)(sk_ + wu * 1024), (LAS unsigned*)(lds + (ko_) + wu * 1024), 16, 0, 0); \
        __builtin_amdgcn_global_load_lds((const GAS unsigned*)s1_, (LAS unsigned*)(lds + d1_), 16, 0, 0); \
        __builtin_amdgcn_global_load_lds((const GAS unsigned*)(sv_ + (16 + wu) * 1024), (LAS unsigned*)(lds + (vo_) + (1 + wu) * 1024), 16, 0, 0); \
    }
#define B_DMA(kt_, vt_, ko_, vo_) B_DMAP(kvb + (size_t)(kt_) * KV_TILE_BYTES, kvb + (size_t)(vt_) * KV_TILE_BYTES, ko_, vo_)
#define B_BARRIER() { if (MODE != 4) { asm volatile("s_waitcnt vmcnt(0) lgkmcnt(0)" ::: "memory"); __builtin_amdgcn_s_barrier(); asm volatile("" ::: "memory"); } }
#define B_QK(S_, ko_)                                                                                 \
    {                                                                                                 \
        const unsigned char* kl_ = lds + (ko_) + koff;                                                \
        u32x4 q6v_ = {q6, 0u, 0u, 0u};                                                                \
        const bf16x8 q6f_ = __builtin_bit_cast(bf16x8, q6v_);                                         \
        _Pragma("unroll") for (int sb = 0; sb < 2; ++sb) {                                            \
            _Pragma("unroll") for (int i = 0; i < 16; ++i) S_[sb][i] = 0.f;                           \
            _Pragma("unroll") for (int ks = 0; ks < 6; ++ks) {                                        \
                const bf16x8 kf_ = *(const bf16x8*)(kl_ + sb * 32 * KROW + ks * 32);                  \
                S_[sb] = MFMA(kf_, qf[ks], S_[sb]);                                                   \
            }                                                                                         \
            S_[sb] = MFMA(kone, q6f_, S_[sb]);                                                        \
        }                                                                                             \
    }
#define B_PV(vo_)                                                                                     \
    {                                                                                                 \
        const unsigned char* vl_ = lds + (vo_) + voff;                                                \
        _Pragma("unroll") for (int sb = 0; sb < 2; ++sb)                                              \
            _Pragma("unroll") for (int s = 0; s < 2; ++s) {                                           \
                const bf16x8 pf_ = __builtin_bit_cast(bf16x8, pw[sb][s]);                             \
                _Pragma("unroll") for (int db = 0; db < 2; ++db) {                                    \
                    const bf16x8 vf_ = (MODE == 5) ? qf[sb * 2 + s] : *(const bf16x8*)(vl_ + db * 32 * 144 + (sb * 32 + s * 16) * 2); \
                    O[db] = MFMA(vf_, pf_, O[db]);                                                    \
                }                                                                                     \
            }                                                                                         \
    }
        if (!staged) {
            B_DMA(0, 0, BK_OFF0, BV_OFF0);
            B_DMA(1, 1, KV_VOFF, BV_OFF0 + BV_SZ);
            { const u32x4 z = {0u, 0u, 0u, 0u}; *(u32x4*)(lds + BV_OFF0 + 2 * BV_SZ + tid * 16) = z; if (tid < 64) *(u32x4*)(lds + BV_OFF0 + 2 * BV_SZ + 8192 + tid * 16) = z; }
            B_BARRIER();
        }
        f32x16 S0[2], S1[2];
        B_QK(S0, BK_OFF0);
        B_BARRIER();
        u32x4 pw[2][2];
#pragma unroll
        for (int sb = 0; sb < 2; ++sb)
#pragma unroll
            for (int s = 0; s < 2; ++s) pw[sb][s] = (u32x4){0u, 0u, 0u, 0u};
        unsigned kcur = BK_OFF0, knext = KV_VOFF;
        unsigned vprev = BV_OFF0 + 2 * BV_SZ, vcur = BV_OFF0, vnext = BV_OFF0 + BV_SZ;
#define B_UNIT(Sa_, j_)                                                                               \
    if (MODE != 3 && MODE != 4) {                                                                     \
        const float e0_ = ex2(Sa_[(j_) >> 3][2 * ((j_) & 7)]), e1_ = ex2(Sa_[(j_) >> 3][2 * ((j_) & 7) + 1]); \
        lt_ += e0_; lt_ += e1_;                                                                       \
        pw[(j_) >> 3][((j_) >> 2) & 1][(j_) & 3] = pk2(e0_, e1_);                                     \
    }
#define B_KFRAG(g_, NKS_) ((MODE == 5) ? qf[(g_) % 6] : (((g_) % (NKS_)) < 6 ? *(const bf16x8*)(kl_ + ((g_) / (NKS_)) * 32 * KROW + ((g_) % (NKS_)) * 32) : kone))
#define B_CHUNK(Sb_, g_, NKS_, kf_)                                                                   \
    {                                                                                                 \
        if (((g_) % (NKS_)) == 0) { _Pragma("unroll") for (int i = 0; i < 16; ++i) Sb_[(g_) / (NKS_)][i] = 0.f; } \
        Sb_[(g_) / (NKS_)] = MFMA(kf_, (((g_) % (NKS_)) < 6 ? qf[((g_) % (NKS_)) < 6 ? ((g_) % (NKS_)) : 0] : q6f_), Sb_[(g_) / (NKS_)]); \
        if ((g_) + 3 < 2 * (NKS_)) kf_ = B_KFRAG((g_) + 3, NKS_);                                     \
    }
#define B_ITER(Sa_, Sb_, kt_)                                                                         \
    {                                                                                                 \
        if (MODE < 2) {                                                                               \
            const GAS unsigned char* kp_ = ((kt_) + 2 < KV_NT) ? kvb + (size_t)((kt_) + 2) * KV_TILE_BYTES : kvn + (size_t)((kt_) + 2 - KV_NT) * KV_TILE_BYTES; \
            const GAS unsigned char* vp_ = ((kt_) + 1 < KV_NT) ? kvb + (size_t)((kt_) + 1) * KV_TILE_BYTES : kvn;                                           \
            B_DMAP(kp_, vp_, kcur, vnext);                                                            \
        }                                                                                             \
        if (MODE != 1) {                                                                              \
                                                                                      \
        B_PV(vprev);                                                                                  \
          \
        float mx = 0.f;                                                                               \
        if ((kt_) == 0 && MODE != 3 && MODE != 4) {                                                   \
        mx = max3f(Sa_[0][0], Sa_[0][1], Sa_[0][2]);                                                  \
        _Pragma("unroll") for (int i = 3; i < 15; i += 2) mx = max3f(mx, Sa_[0][i], Sa_[0][i + 1]);   \
        mx = max3f(mx, Sa_[0][15], Sa_[1][0]);                                                        \
        _Pragma("unroll") for (int i = 1; i < 15; i += 2) mx = max3f(mx, Sa_[1][i], Sa_[1][i + 1]);   \
        mx = fmaxf(mx, Sa_[1][15]);                                                                   \
        mx = fmaxf(mx, __shfl_xor(mx, 32));                                                           \
        }                                                                                             \
        if ((kt_) == 0 && __any((mx > DEFER_THR) || (mx < -DEFER_THR))) {                             \
            const float mnew = bflo(pk2(m + mx, 0.f) & 0xffffu);                                      \
            const float delta = mnew - m;                                                             \
            const float alpha = ex2(-delta);                                                          \
            m = mnew; l *= alpha;                                                                     \
            q6 = hh ? 0u : (pk2(-mnew, 0.f) & 0xffffu);                                               \
            refnz = refnz || __any(mnew != 0.f);                                                      \
            _Pragma("unroll") for (int i = 0; i < 16; ++i) { O[0][i] *= alpha; O[1][i] *= alpha; Sa_[0][i] -= delta; Sa_[1][i] -= delta; } \
        }                                                                                             \
           \
        float lt_ = 0.f;                                                                              \
        {                                                                                             \
            const unsigned char* kl_ = lds + knext + koff;                                            \
            u32x4 q6v_ = {q6, 0u, 0u, 0u};                                                            \
            const bf16x8 q6f_ = __builtin_bit_cast(bf16x8, q6v_);                                     \
            if (refnz) { \
            { bf16x8 kfa_ = B_KFRAG(0, 7), kfb_ = B_KFRAG(1, 7), kfc_ = B_KFRAG(2, 7); \
            B_CHUNK(Sb_, 0, 7, kfa_) B_UNIT(Sa_, 0) B_UNIT(Sa_, 1) __builtin_amdgcn_sched_barrier(0); \
            B_CHUNK(Sb_, 1, 7, kfb_) B_UNIT(Sa_, 2) B_UNIT(Sa_, 3) __builtin_amdgcn_sched_barrier(0); \
            B_CHUNK(Sb_, 2, 7, kfc_) B_UNIT(Sa_, 4) __builtin_amdgcn_sched_barrier(0); \
            B_CHUNK(Sb_, 3, 7, kfa_) B_UNIT(Sa_, 5) __builtin_amdgcn_sched_barrier(0); \
            B_CHUNK(Sb_, 4, 7, kfb_) B_UNIT(Sa_, 6) __builtin_amdgcn_sched_barrier(0); \
            B_CHUNK(Sb_, 5, 7, kfc_) B_UNIT(Sa_, 7) __builtin_amdgcn_sched_barrier(0); \
            B_CHUNK(Sb_, 6, 7, kfa_) B_UNIT(Sa_, 8) __builtin_amdgcn_sched_barrier(0); \
            B_CHUNK(Sb_, 7, 7, kfb_) B_UNIT(Sa_, 9) __builtin_amdgcn_sched_barrier(0); \
            B_CHUNK(Sb_, 8, 7, kfc_) B_UNIT(Sa_, 10) __builtin_amdgcn_sched_barrier(0); \
            B_CHUNK(Sb_, 9, 7, kfa_) B_UNIT(Sa_, 11) __builtin_amdgcn_sched_barrier(0); \
            B_CHUNK(Sb_, 10, 7, kfb_) B_UNIT(Sa_, 12) __builtin_amdgcn_sched_barrier(0); \
            B_CHUNK(Sb_, 11, 7, kfc_) B_UNIT(Sa_, 13) __builtin_amdgcn_sched_barrier(0); \
            B_CHUNK(Sb_, 12, 7, kfa_) B_UNIT(Sa_, 14) __builtin_amdgcn_sched_barrier(0); \
            B_CHUNK(Sb_, 13, 7, kfb_) B_UNIT(Sa_, 15) __builtin_amdgcn_sched_barrier(0); \
            } \
            } else { \
            { bf16x8 kfa_ = B_KFRAG(0, 6), kfb_ = B_KFRAG(1, 6), kfc_ = B_KFRAG(2, 6); \
            B_CHUNK(Sb_, 0, 6, kfa_) B_UNIT(Sa_, 0) B_UNIT(Sa_, 1) __builtin_amdgcn_sched_barrier(0); \
            B_CHUNK(Sb_, 1, 6, kfb_) B_UNIT(Sa_, 2) B_UNIT(Sa_, 3) __builtin_amdgcn_sched_barrier(0); \
            B_CHUNK(Sb_, 2, 6, kfc_) B_UNIT(Sa_, 4) B_UNIT(Sa_, 5) __builtin_amdgcn_sched_barrier(0); \
            B_CHUNK(Sb_, 3, 6, kfa_) B_UNIT(Sa_, 6) B_UNIT(Sa_, 7) __builtin_amdgcn_sched_barrier(0); \
            B_CHUNK(Sb_, 4, 6, kfb_) B_UNIT(Sa_, 8) __builtin_amdgcn_sched_barrier(0); \
            B_CHUNK(Sb_, 5, 6, kfc_) B_UNIT(Sa_, 9) __builtin_amdgcn_sched_barrier(0); \
            B_CHUNK(Sb_, 6, 6, kfa_) B_UNIT(Sa_, 10) __builtin_amdgcn_sched_barrier(0); \
            B_CHUNK(Sb_, 7, 6, kfb_) B_UNIT(Sa_, 11) __builtin_amdgcn_sched_barrier(0); \
            B_CHUNK(Sb_, 8, 6, kfc_) B_UNIT(Sa_, 12) __builtin_amdgcn_sched_barrier(0); \
            B_CHUNK(Sb_, 9, 6, kfa_) B_UNIT(Sa_, 13) __builtin_amdgcn_sched_barrier(0); \
            B_CHUNK(Sb_, 10, 6, kfb_) B_UNIT(Sa_, 14) __builtin_amdgcn_sched_barrier(0); \
            B_CHUNK(Sb_, 11, 6, kfc_) B_UNIT(Sa_, 15) __builtin_amdgcn_sched_barrier(0); \
            } \
            } \
        }                                                                                             \
          \
        if (MODE != 3 && MODE != 4 && __any(!(lt_ <= 1.0995116e12f))) {                                \
            float mx2 = max3f(Sa_[0][0], Sa_[0][1], Sa_[0][2]);                                       \
            _Pragma("unroll") for (int i = 3; i < 15; i += 2) mx2 = max3f(mx2, Sa_[0][i], Sa_[0][i + 1]); \
            mx2 = max3f(mx2, Sa_[0][15], Sa_[1][0]);                                                   \
            _Pragma("unroll") for (int i = 1; i < 15; i += 2) mx2 = max3f(mx2, Sa_[1][i], Sa_[1][i + 1]); \
            mx2 = fmaxf(mx2, Sa_[1][15]);                                                             \
            mx2 = fmaxf(mx2, __shfl_xor(mx2, 32));                                                    \
            const float mnew = bflo(pk2(m + mx2, 0.f) & 0xffffu);                                     \
            const float delta = mnew - m;                                                             \
            const float alpha = ex2(-delta);                                                          \
            m = mnew; l *= alpha;                                                                     \
            q6 = hh ? 0u : (pk2(-mnew, 0.f) & 0xffffu);                                               \
            refnz = refnz || __any(mnew != 0.f);                                                      \
            lt_ = 0.f;                                                                                \
            _Pragma("unroll") for (int i = 0; i < 16; ++i) { O[0][i] *= alpha; O[1][i] *= alpha; Sb_[0][i] -= delta; Sb_[1][i] -= delta; } \
            _Pragma("unroll") for (int j = 0; j < 16; ++j) {                                          \
                const float e0_ = ex2(Sa_[j >> 3][2 * (j & 7)] - delta), e1_ = ex2(Sa_[j >> 3][2 * (j & 7) + 1] - delta); \
                lt_ += e0_; lt_ += e1_;                                                               \
                pw[j >> 3][(j >> 2) & 1][j & 3] = pk2(e0_, e1_);                                      \
            }                                                                                         \
        }                                                                                             \
        l += lt_;                                                                                     \
        }                                                                                             \
                                               \
        B_BARRIER(); \
        { const unsigned t_ = kcur; kcur = knext; knext = t_; }                                       \
        { const unsigned t_ = vprev; vprev = vcur; vcur = vnext; vnext = t_; }                        \
    }
        for (int kt = 0; kt < KV_NT; kt += 2) {
            B_ITER(S0, S1, kt)
            B_ITER(S1, S0, kt + 1)
        }
#undef B_ITER
#undef B_CHUNK
#undef B_KFRAG
#undef B_UNIT
        B_PV(vprev);
#undef B_DMA
#undef B_DMAP
#undef B_QK
#undef B_PV
        staged = has_next;
        if (MODE == 0) attn_store(O, l, sg, og, (size_t)(t0 + r) * 1024 + h * 64, hh);
        else { float acc_ = l + m; _Pragma("unroll") for (int i = 0; i < 16; ++i) acc_ += O[0][i] + O[1][i] + S0[0][i] + S0[1][i] + S1[0][i] + S1[1][i]; if (acc_ == 123.456f) og[0] = 0; }
        __syncthreads();
    }
    __builtin_amdgcn_s_setprio(0);
}

DI void final_norm_phase(const float* g, const bf16_t* x2b, float* out, int tid) {
    const int lane = tid & 63, gw = blockIdx.x * 8 + (tid >> 6), ngw = gridDim.x * 8;
    for (int row0 = gw; row0 < MLAT; row0 += 2 * ngw) {
        f32x4 v[2][4]; bool ok[2]; int row[2];
#pragma unroll
        for (int q = 0; q < 2; ++q) {
            row[q] = row0 + q * ngw; ok[q] = row[q] < MLAT;
            const bf16_t* src = x2b + (size_t)(ok[q] ? row[q] : row0) * D;
#pragma unroll
            for (int j = 0; j < 4; ++j) { const u32x2 b2 = *(const GAS u32x2*)(src + lane * 4 + 256 * j); v[q][j] = (f32x4){bflo(b2.x), bfhi(b2.x), bflo(b2.y), bfhi(b2.y)}; }
        }
#pragma unroll
        for (int q = 0; q < 2; ++q) {
            float ss = 0.f;
#pragma unroll
            for (int j = 0; j < 4; ++j) ss += (v[q][j].x * v[q][j].x + v[q][j].y * v[q][j].y) + (v[q][j].z * v[q][j].z + v[q][j].w * v[q][j].w);
            const float rstd = 1.f / sqrtf(wave_sum(ss) * (1.f / D) + EPS);
            if (ok[q]) {
#pragma unroll
                for (int j = 0; j < 4; ++j) { const f32x4 gg = *(const GAS f32x4*)(g + lane * 4 + 256 * j); *(GAS f32x4*)(out + (size_t)row[q] * D + lane * 4 + 256 * j) = v[q][j] * rstd * gg; }
            }
        }
    }
}

#define XB_TMO      128
#define XB_XCNT(j)  (256  + 64 * (j))
#define XB_XSUB(j)  (1280 + 64 * (j))
#define XB_XGEN(j)  (2304 + 64 * (j))
#define XB_TOP      3328
#define XB_TOPGEN   3392
#define XCD_BAR_WORDS 3456
#define XB_SPIN_CAP (1u << 18)
DI unsigned xb_ld(unsigned* p)              { return __hip_atomic_load(p, __ATOMIC_RELAXED, __HIP_MEMORY_SCOPE_AGENT); }
DI unsigned xb_add(unsigned* p, unsigned v) { return __hip_atomic_fetch_add(p, v, __ATOMIC_RELAXED, __HIP_MEMORY_SCOPE_AGENT); }
DI unsigned xb_xcc_id() { return (unsigned)__builtin_amdgcn_s_getreg((3 << 11) | 20) & 0xFu; }
#define XB_SPIN(cond, bar) do { unsigned _sp = 0; while (cond) { __builtin_amdgcn_s_sleep(1); \
    if ((++_sp & 255u) == 0u) { if (xb_ld(&(bar)[XB_TMO])) break; if (_sp > XB_SPIN_CAP) { atomicAdd(&(bar)[XB_TMO], 1u); break; } } } } while (0)
struct XcdBarrier { unsigned* bar; unsigned x; volatile LAS unsigned* st; };
DI XcdBarrier xcd_barrier_post(unsigned* bar, volatile LAS unsigned* st) {
    XcdBarrier b; b.bar = bar; b.x = xb_xcc_id(); b.st = st;
    if (threadIdx.x == 0) (void)xb_add(&bar[XB_XCNT(b.x)], 1u);
    return b;
}
DI void xcd_barrier_complete(unsigned* bar, unsigned x, unsigned& nloc, unsigned& nx) {
    const unsigned G = gridDim.x * gridDim.y * gridDim.z;
    unsigned sum, cnt, mine, sp = 0u;
    for (;;) {
        sum = 0u; cnt = 0u; mine = 0u;
#pragma unroll
        for (unsigned j = 0; j < 16; ++j) { const unsigned c = xb_ld(&bar[XB_XCNT(j)]); sum += c; cnt += (c > 0u) ? 1u : 0u; mine = (j == x) ? c : mine; }
        if (sum == G) break;
        __builtin_amdgcn_s_sleep(1);
        if ((++sp & 255u) == 0u) { if (xb_ld(&bar[XB_TMO])) break; if (sp > XB_SPIN_CAP) { atomicAdd(&bar[XB_TMO], 1u); break; } }
    }
    nloc = mine > 0u ? mine : 1u; nx = cnt > 0u ? cnt : 1u;
}
DI void xcd_barrier(const XcdBarrier& b) {
    asm volatile("s_waitcnt vmcnt(0)" ::: "memory");
    __syncthreads();
    if (threadIdx.x == 0) {
        unsigned* bar = b.bar;
        __builtin_amdgcn_s_waitcnt(0);
        unsigned nloc = b.st[0], nx = b.st[1];
        if (nloc == 0u) { xcd_barrier_complete(bar, b.x, nloc, nx); b.st[0] = nloc; b.st[1] = nx; }
        const unsigned old = xb_add(&bar[XB_XSUB(b.x)], 1u);
        const unsigned gen = old / nloc;
        if (old + 1u == (gen + 1u) * nloc) {
            __builtin_amdgcn_fence(__ATOMIC_RELEASE, "agent");
            asm volatile("s_waitcnt vmcnt(0)" ::: "memory");
            const unsigned og = xb_add(&bar[XB_TOP], 1u);
            const unsigned tg = og / nx;
            if (og + 1u == (tg + 1u) * nx) xb_add(&bar[XB_TOPGEN], 1u);
            else XB_SPIN(xb_ld(&bar[XB_TOPGEN]) == tg, bar);
            __builtin_amdgcn_fence(__ATOMIC_ACQUIRE, "agent");
            xb_add(&bar[XB_XGEN(b.x)], 1u);
            asm volatile("s_waitcnt vmcnt(0)" ::: "memory");
        } else {
            XB_SPIN(xb_ld(&bar[XB_XGEN(b.x)]) == gen, bar);
            __builtin_amdgcn_fence(__ATOMIC_ACQUIRE, "agent");
            asm volatile("s_waitcnt vmcnt(0)" ::: "memory");
        }
    }
    __syncthreads();
}

__device__ constexpr int PROBE_REP[12] = {1, 1, 1, 1, 1, 1, 1, 1, 1, 1, 1, 1};
#ifndef ONLY_PHASE
#define PH_SEL(k_) true
#else
#define PH_SEL(k_) ((k_) == ONLY_PHASE)
#endif
#define PH_BEGIN(k_) if (PH_SEL(k_) && p.ph_lo <= (k_) && (k_) < p.ph_hi) { unsigned char* ws = p.ws; float* out = p.out; int nrep_ = PROBE_REP[k_]; asm volatile("" : "+s"(ws), "+s"(out), "+s"(nrep_)); const float* mods = (const float*)(ws + WS_MODS); (void)mods; (void)out; for (int rep_ = 0; rep_ < nrep_; ++rep_) { if (rep_) __syncthreads();
#define PH_END(k_) } } if (p.ph_lo <= (k_) && (k_) + 1 < p.ph_hi) xcd_barrier(xb);
extern "C" __global__ void __launch_bounds__(512) mega_fwd(Params p) {
    extern __shared__ __attribute__((aligned(16))) unsigned char lds[];
    const int tid = threadIdx.x;
    __shared__ uint4 xb_words;
    if (tid == 0) xb_words = make_uint4(0u, 0u, 0u, 0u);
    __syncthreads();
    XcdBarrier xb; xb.bar = (unsigned*)(p.ws + WS_BAR); xb.x = 0; xb.st = (volatile LAS unsigned*)&xb_words;
    if (p.ph_hi - p.ph_lo > 1) xb = xcd_barrier_post((unsigned*)(p.ws + WS_BAR), (volatile LAS unsigned*)&xb_words);
    if (p.ph_lo < 0) cg::this_grid().sync();
    PH_BEGIN(0) phase0(p, ws, lds, tid); PH_END(0)
    PH_BEGIN(1) modulate_phase<false>(p.in[0], p.in[2], p.in[4], mods, (bf16_t*)(ws + WS_H), tid); PH_END(1)
    PH_BEGIN(2) EpiAin e{(bf16_t*)(ws + WS_Q0), (bf16_t*)(ws + WS_K0), (bf16_t*)(ws + WS_VT0), (bf16_t*)(ws + WS_SG), (const f32x2*)(ws + WS_ROPEA), lds + 131072 + (tid >> 6) * 2560};
        gemm_phase((const bf16_t*)(ws + WS_H), (const bf16_t*)(ws + WS_WT_IN0), MTOT / 256, 2560 / 256, 1024, e, lds, tid); PH_END(2)
    PH_BEGIN(3) attn_a_phase(p, ws, lds, tid); PH_END(3)
    PH_BEGIN(4) EpiWo0 e{p.in[0], (bf16_t*)out, p.in[2], (float*)(ws + WS_CTX1), mods};
        gemm_phase<EpiWo0, 2>((const bf16_t*)(ws + WS_OG0), (const bf16_t*)(ws + WS_WT_O0), MTOT / 128, 1024 / 256, 1024, e, lds, tid); PH_END(4)
    PH_BEGIN(5) modulate_phase<true>(out, (const float*)(ws + WS_CTX1), p.in[10], mods + 3 * 3072, (bf16_t*)(ws + WS_H), tid); PH_END(5)
    PH_BEGIN(6) EpiBin e{(bf16_t*)(ws + WS_CQN), (bf16_t*)(ws + WS_CKVN), (float*)(ws + WS_SSQ), ws + WS_KV, (const f32x2*)(ws + WS_ROPEB), (bf16_t*)(ws + WS_SG)};
        gemm_phase((const bf16_t*)(ws + WS_H), (const bf16_t*)(ws + WS_WT_IN1), MTOT / 256, 1536 / 256, 1024, e, lds, tid); PH_END(6)
    PH_BEGIN(8) EpiUq e{(bf16_t*)(ws + WS_Q1), (const f32x2*)(ws + WS_ROPEB), (const float*)(ws + WS_SSQ)};
        gemm_phase<EpiUq, 2>((const bf16_t*)(ws + WS_CQN), (const bf16_t*)(ws + WS_WT_UQ), MLAT / 128, 1536 / 256, 256, e, lds, tid);
        EpiUkv e2{ws + WS_KV, lds + 131072 + (tid >> 6) * 2560, (const float*)(ws + WS_SSQ)};
        gemm_phase<EpiUkv, 2>((const bf16_t*)(ws + WS_CKVN), (const bf16_t*)(ws + WS_WT_UKV), MTOT / 128, 2048 / 256, 128, e2, lds, tid); PH_END(8)
    PH_BEGIN(9) attn_b_phase<0>(ws, lds, tid); PH_END(9)
    PH_BEGIN(10) EpiWo1 e{(const bf16_t*)out, (bf16_t*)(ws + WS_Q1), mods + 3 * 3072};
        gemm_phase((const bf16_t*)(ws + WS_H), (const bf16_t*)(ws + WS_WT_O1), MLAT / 256, 1024 / 256, 1024, e, lds, tid); PH_END(10)
    PH_BEGIN(11) final_norm_phase(p.in[19], (const bf16_t*)(ws + WS_Q1), out, tid); PH_END(11)
}

extern "C" void kernel_launch(void* const* d_in, const int* in_sizes, int n_in, void* d_out, int out_size, void* d_ws, size_t ws_size, hipStream_t stream) {
    static int grid = 0;
    if (grid == 0) {
        if (n_in != 20 || ws_size < WS_END) { fprintf(stderr, "kernel_launch: unexpected n_in %d or ws_size %zu (< %zu)\n", n_in, ws_size, (size_t)WS_END); grid = -1; return; }
        int dev = 0, cus = 0, per_cu = 0;
        hipGetDevice(&dev);
        hipDeviceGetAttribute(&cus, hipDeviceAttributeMultiprocessorCount, dev);
        if (hipFuncSetAttribute((const void*)mega_fwd, hipFuncAttributeMaxDynamicSharedMemorySize, LDS_BYTES) != hipSuccess) { fprintf(stderr, "kernel_launch: hipFuncSetAttribute failed\n"); }
        if (hipOccupancyMaxActiveBlocksPerMultiprocessor(&per_cu, (const void*)mega_fwd, 512, LDS_BYTES) != hipSuccess || per_cu < 1) { fprintf(stderr, "kernel_launch: occupancy query says %d\n", per_cu); per_cu = 1; }
        (void)hipGetLastError();
        grid = cus * per_cu;
        if (grid <= 0) grid = 256;
    }
    if (grid < 0) return;
    Params p{};
    for (int i = 0; i < 20; ++i) p.in[i] = (const float*)d_in[i];
    p.out = (float*)d_out; p.ws = (unsigned char*)d_ws;
#if N_LAUNCH_MODE == 1
    p.ph_lo = 0; p.ph_hi = NPHASE;
    (void)hipMemsetAsync((unsigned char*)d_ws + WS_BAR, 0, 16384, stream);
    void* args[] = {&p};
    hipError_t e = hipLaunchCooperativeKernel((const void*)mega_fwd, dim3(grid), dim3(512), args, LDS_BYTES, stream);
    if (e != hipSuccess) fprintf(stderr, "cooperative launch failed: %s (grid %d)\n", hipGetErrorString(e), grid);
#else
    for (int ph = 0; ph < NPHASE; ++ph) {
        p.ph_lo = ph; p.ph_hi = ph + 1;
        hipLaunchKernelGGL(mega_fwd, dim3(grid), dim3(512), LDS_BYTES, stream, p);
    }
#endif
}
```
